# Optimizing an MI355X kernel written in HIP

```python
import math
import jax, jax.numpy as jnp
from jax import lax
import numpy as np

D_MODEL = 2048
BATCH = 4
SEQ = 2048
DEPTH = 4

GRID_W = 64
CTX_LEN = 256
N_MIXERS = 4
DEEPNORM_ALPHA = (2 * DEPTH) ** 0.25
DEEPNORM_BETA = (8 * DEPTH) ** -0.25
LN_EPS = 1e-5
ADA_CHUNKS = 6
D_FF = 4 * D_MODEL
BLOCK = 128
ROPE_BASE = 10000.0
NEG_INF = -1e30

LRU_WIDTH = D_MODEL
LRU_BLOCK_W = 256
LRU_BLOCKS = LRU_WIDTH // LRU_BLOCK_W
LRU_CONV_W = 4
LRU_C = 8.0

DIF_HEADS = 16
DIF_DH = 64
DIF_DV = 2 * DIF_DH

RET_HEADS = 8
RET_DK = D_MODEL // RET_HEADS
RET_DV = 2 * RET_DK
RET_CHUNK = 128

SWA_HEADS = 32
SWA_KV_HEADS = 8
SWA_GROUP = SWA_HEADS // SWA_KV_HEADS
SWA_DH = 64
WINDOW = 128

F32 = jnp.float32

kernel_name = 'hybrid_interleaved_flow_block'


def layer_norm(x, g, b):
    xf = x.astype(F32)
    mu = jnp.mean(xf, -1, keepdims=True)
    var = jnp.mean(jnp.square(xf - mu), -1, keepdims=True)
    y = (xf - mu) * lax.rsqrt(var + LN_EPS)
    return (y * g.astype(F32) + b.astype(F32)).astype(x.dtype)


def rms_norm(x, g=None):
    xf = x.astype(F32)
    y = xf * lax.rsqrt(jnp.mean(jnp.square(xf), -1, keepdims=True) + LN_EPS)
    if g is not None:
        y = y * g.astype(F32)
    return y.astype(x.dtype)


def axial_rope_tables(rows, head_dim):
    row = jnp.repeat(jnp.arange(rows, dtype=F32), GRID_W)
    col = jnp.tile(jnp.arange(GRID_W, dtype=F32), rows)
    half = head_dim // 2
    inv_freq = ROPE_BASE ** (-jnp.arange(0, half, 2, dtype=F32) / half)
    ang_r = row[:, None] * inv_freq[None, :]
    ang_c = col[:, None] * inv_freq[None, :]
    ang = jnp.concatenate([ang_r, ang_r, ang_c, ang_c], -1)
    return jnp.cos(ang), jnp.sin(ang)


def apply_rope(x, cos, sin):
    shape = (1, cos.shape[0]) + (1,) * (x.ndim - 3) + (cos.shape[1],)
    x1, x2, x3, x4 = jnp.split(x, 4, axis=-1)
    rot = jnp.concatenate([-x2, x1, -x4, x3], -1)
    return (x * cos.reshape(shape) + rot * sin.reshape(shape)).astype(x.dtype)


def squared_relu_mlp(u, w1, w2):
    return jnp.square(jax.nn.relu(u @ w1)) @ w2


def depthwise_conv_centred(x, w, b):
    k = w.shape[0]
    left = k // 2
    right = k - 1 - left
    y = lax.conv_general_dilated(x, w[:, None, :], (1,), [(left, right)],
                                 dimension_numbers=('NWC', 'WIO', 'NWC'),
                                 feature_group_count=x.shape[-1])
    return y + b


def block_diag(x, w):
    nb, bw, _ = w.shape
    xb = x.reshape(x.shape[:-1] + (nb, bw))
    return jnp.einsum('bsnc,ncd->bsnd', xb, w).reshape(x.shape)


def rglru_coeffs(xc, w_gate, b_gate, lam):
    r = jax.nn.sigmoid((block_diag(xc, w_gate[0]) + b_gate[0]).astype(F32))
    i = jax.nn.sigmoid((block_diag(xc, w_gate[1]) + b_gate[1]).astype(F32))
    log_a = -LRU_C * r * jax.nn.softplus(-lam.astype(F32))
    a = jnp.exp(log_a)
    b = jnp.sqrt(-jnp.expm1(2.0 * log_a)) * (i * xc.astype(F32))
    return a, b


def linear_scan(a, b, h0=None):
    def combine(left, right):
        return left[0] * right[0], right[0] * left[1] + right[1]
    a_cum, h = lax.associative_scan(combine, (a, b), axis=1)
    if h0 is not None:
        h = h + a_cum * h0[:, None, :]
    return h


def rglru_direction(x_c, x_l, w_gate, b_gate, lam, reverse):
    fl = (lambda t: jnp.flip(t, 1)) if reverse else (lambda t: t)
    a_c, b_c = rglru_coeffs(fl(x_c), w_gate, b_gate, lam)
    h_c = linear_scan(a_c, b_c)
    a_l, b_l = rglru_coeffs(fl(x_l), w_gate, b_gate, lam)
    h_l = linear_scan(a_l, b_l, h_c[:, -1])
    return fl(h_c), fl(h_l)


def rglru_mixer(u_lat, u_ctx, w_in, conv_w, conv_b, gate_w, gate_b, lam, w_out, ctx_out):
    def branches(u):
        gate_br, rec_br = jnp.split(u @ w_in, 2, -1)
        return jax.nn.gelu(gate_br), depthwise_conv_centred(rec_br, conv_w, conv_b)
    gate_c, x_c = branches(u_ctx)
    gate_l, x_l = branches(u_lat)
    hc_f, hl_f = rglru_direction(x_c, x_l, gate_w[0], gate_b[0], lam[0], False)
    hc_b, hl_b = rglru_direction(x_c, x_l, gate_w[1], gate_b[1], lam[1], True)
    y_lat = (gate_l * (hl_f + hl_b).astype(gate_l.dtype)) @ w_out
    if not ctx_out:
        return y_lat, None
    y_ctx = (gate_c * (hc_f + hc_b).astype(gate_c.dtype)) @ w_out
    return y_lat, y_ctx


def diff_attention_mixer(u_lat, u_ctx, w_qkv, lam, subln, w_out, cos, sin, layer_idx, ctx_out):
    B, S, _ = u_lat.shape
    scale = DIF_DH ** -0.5
    lam_init = 0.8 - 0.6 * math.exp(-0.3 * layer_idx)
    lam_full = (jnp.exp(jnp.sum(lam[0] * lam[1]).astype(F32))
                - jnp.exp(jnp.sum(lam[2] * lam[3]).astype(F32)) + lam_init)

    def proj(u):
        q, k, v = jnp.split(u @ w_qkv, 3, -1)
        n = u.shape[:2]
        return (q.reshape(n + (DIF_HEADS, 2, DIF_DH)), k.reshape(n + (DIF_HEADS, 2, DIF_DH)),
                v.reshape(n + (DIF_HEADS, DIF_DV)))

    q_l, k_l, v_l = proj(u_lat)
    q_c, k_c, v_c = proj(u_ctx)
    q_l = apply_rope(q_l, cos, sin)
    k_l = apply_rope(k_l, cos, sin)
    k_all = jnp.concatenate([k_l, k_c], 1)
    v_all = jnp.concatenate([v_l, v_c], 1)

    def attend(q, k, v):
        s = jnp.einsum('bqhmd,bkhmd->bhmqk', q, k).astype(F32) * scale
        p = jax.nn.softmax(s, -1)
        attn = p[:, :, 0] - lam_full * p[:, :, 1]
        return jnp.einsum('bhqk,bkhe->bqhe', attn.astype(v.dtype), v)

    def finish(o):
        o = rms_norm(o, subln) * (1.0 - lam_init)
        return o.reshape(o.shape[:2] + (DIF_HEADS * DIF_DV,)) @ w_out

    nb = S // BLOCK
    q_blocks = jnp.moveaxis(q_l.reshape(B, nb, BLOCK, DIF_HEADS, 2, DIF_DH), 1, 0)
    o = lax.map(lambda qb: attend(qb, k_all, v_all), q_blocks)
    y_lat = finish(jnp.moveaxis(o, 0, 1).reshape(B, S, DIF_HEADS, DIF_DV))
    if not ctx_out:
        return y_lat, None
    y_ctx = finish(attend(q_c, k_c, v_c))
    return y_lat, y_ctx


def retention_log_decays():
    log_gf = jnp.log1p(-jnp.exp2(-5.0 - jnp.arange(RET_HEADS, dtype=F32)))
    return log_gf, log_gf[::-1]


def retention_intra(q, k, v, log_gf, log_gb):
    C = q.shape[2]
    idx = jnp.arange(C)
    rel = (idx[:, None] - idx[None, :]).astype(F32)
    lg = jnp.where(rel[None] >= 0, log_gf[:, None, None], log_gb[:, None, None])
    decay = jnp.exp(jnp.abs(rel)[None] * lg)
    s = jnp.einsum('bnihd,bnjhd->bnhij', q, k) * decay
    return jnp.einsum('bnhij,bnjhe->bnihe', s, v)


def retention_inter(q, k, v, log_g, state0=None):
    B, N, C, H, dk = q.shape
    dv = v.shape[-1]
    pos = jnp.arange(C, dtype=F32)[:, None]
    q_dec = jnp.exp((pos + 1.0) * log_g)
    k_dec = jnp.exp((C - 1.0 - pos) * log_g)
    c_dec = jnp.exp(C * log_g)[:, None, None]
    if state0 is None:
        state0 = jnp.zeros((B, H, dk, dv), F32)

    def step(R, xs):
        qc, kc, vc = xs
        out = jnp.einsum('bihd,bhde->bihe', qc * q_dec[:, :, None], R)
        R = c_dec * R + jnp.einsum('bjhd,bjhe->bhde', kc * k_dec[:, :, None], vc)
        return R, out

    R, out = lax.scan(step, state0, (jnp.moveaxis(q, 1, 0), jnp.moveaxis(k, 1, 0), jnp.moveaxis(v, 1, 0)))
    return jnp.moveaxis(out, 0, 1), R


def retention_mixer(u_lat, u_ctx, w_qkvg, w_out, ctx_out):
    log_gf, log_gb = retention_log_decays()

    def proj(u):
        q, k, v, g = jnp.split(u @ w_qkvg, [D_MODEL, 2 * D_MODEL, 2 * D_MODEL + RET_HEADS * RET_DV], -1)
        n = u.shape[:2]
        q = q.reshape(n + (RET_HEADS, RET_DK)).astype(F32) * (RET_DK ** -0.5)
        k = k.reshape(n + (RET_HEADS, RET_DK)).astype(F32)
        v = v.reshape(n + (RET_HEADS, RET_DV)).astype(F32)
        return q, k, v, g

    def chunks(t):
        return t.reshape((t.shape[0], t.shape[1] // RET_CHUNK, RET_CHUNK) + t.shape[2:])

    def unchunk(t):
        return t.reshape((t.shape[0], t.shape[1] * t.shape[2]) + t.shape[3:])

    def rev(t):
        return jnp.flip(t, 1)

    def finish(q, k, v, g, inter_f, inter_b):
        B, S = q.shape[:2]
        o = unchunk(retention_intra(chunks(q), chunks(k), chunks(v), log_gf, log_gb) + inter_f) + rev(unchunk(inter_b))
        o = rms_norm(o).reshape(B, S, RET_HEADS * RET_DV)
        return (jax.nn.silu(g) * o.astype(g.dtype)) @ w_out

    q_c, k_c, v_c, g_c = proj(u_ctx)
    q_l, k_l, v_l, g_l = proj(u_lat)
    inter_cf, s_f = retention_inter(chunks(q_c), chunks(k_c), chunks(v_c), log_gf)
    inter_cb, s_b = retention_inter(chunks(rev(q_c)), chunks(rev(k_c)), chunks(rev(v_c)), log_gb)
    inter_lf, _ = retention_inter(chunks(q_l), chunks(k_l), chunks(v_l), log_gf, s_f)
    inter_lb, _ = retention_inter(chunks(rev(q_l)), chunks(rev(k_l)), chunks(rev(v_l)), log_gb, s_b)
    y_lat = finish(q_l, k_l, v_l, g_l, inter_lf, inter_lb)
    if not ctx_out:
        return y_lat, None
    y_ctx = finish(q_c, k_c, v_c, g_c, inter_cf, inter_cb)
    return y_lat, y_ctx


def window_gqa_mixer(u_lat, u_ctx, w_qkv, sink, w_out, cos, sin, ctx_out):
    B, S, _ = u_lat.shape
    L = u_ctx.shape[1]
    scale = SWA_DH ** -0.5

    def proj(u):
        q, k, v = jnp.split(u @ w_qkv, [SWA_HEADS * SWA_DH, (SWA_HEADS + SWA_KV_HEADS) * SWA_DH], -1)
        n = u.shape[:2]
        return (q.reshape(n + (SWA_KV_HEADS, SWA_GROUP, SWA_DH)), k.reshape(n + (SWA_KV_HEADS, SWA_DH)),
                v.reshape(n + (SWA_KV_HEADS, SWA_DH)))

    q_l, k_l, v_l = proj(u_lat)
    q_c, k_c, v_c = proj(u_ctx)
    q_l = apply_rope(q_l, cos, sin)
    k_l = apply_rope(k_l, cos, sin)
    sink_hg = sink.astype(F32).reshape(SWA_KV_HEADS, SWA_GROUP)

    def softmax_with_sink(s):
        col = jnp.broadcast_to(sink_hg[None, :, :, None, None], s.shape[:-1] + (1,))
        return jax.nn.softmax(jnp.concatenate([s, col], -1), -1)[..., :-1]

    span = BLOCK + 2 * WINDOW
    k_pad = jnp.pad(k_l, ((0, 0), (WINDOW, WINDOW), (0, 0), (0, 0)))
    v_pad = jnp.pad(v_l, ((0, 0), (WINDOW, WINDOW), (0, 0), (0, 0)))
    rel = (jnp.arange(span)[None, :] - WINDOW) - jnp.arange(BLOCK)[:, None]
    band = jnp.abs(rel) <= WINDOW

    def block(n):
        start = n * BLOCK
        qb = lax.dynamic_slice_in_dim(q_l, start, BLOCK, 1)
        kb = lax.dynamic_slice_in_dim(k_pad, start, span, 1)
        vb = lax.dynamic_slice_in_dim(v_pad, start, span, 1)
        kpos = start - WINDOW + jnp.arange(span)
        valid = band & ((kpos >= 0) & (kpos < S))[None, :]
        s_win = jnp.where(valid, jnp.einsum('bqhgd,bshd->bhgqs', qb, kb).astype(F32) * scale, NEG_INF)
        s_ctx = jnp.einsum('bqhgd,bchd->bhgqc', qb, k_c).astype(F32) * scale
        p = softmax_with_sink(jnp.concatenate([s_win, s_ctx], -1)).astype(vb.dtype)
        return (jnp.einsum('bhgqs,bshd->bqhgd', p[..., :span], vb)
                + jnp.einsum('bhgqc,bchd->bqhgd', p[..., span:], v_c))

    o = lax.map(block, jnp.arange(S // BLOCK))
    y_lat = jnp.moveaxis(o, 0, 1).reshape(B, S, SWA_HEADS * SWA_DH) @ w_out
    if not ctx_out:
        return y_lat, None
    s_cc = jnp.einsum('bqhgd,bchd->bhgqc', q_c, k_c).astype(F32) * scale
    o_c = jnp.einsum('bhgqc,bchd->bqhgd', softmax_with_sink(s_cc).astype(v_c.dtype), v_c)
    y_ctx = o_c.reshape(B, L, SWA_HEADS * SWA_DH) @ w_out
    return y_lat, y_ctx


def setup_inputs(seed: int = 0) -> dict:
    key = jax.random.key(seed)
    ks = iter(jax.random.split(key, 32))
    D = D_MODEL

    def nrm(shape, scale):
        return jax.random.normal(next(ks), shape, F32) * scale

    def uses(kind):
        return len(range(kind, DEPTH, N_MIXERS))

    def lru_lambda_init(shape):
        a = jax.random.uniform(next(ks), shape, F32, 0.9, 0.999) ** (1.0 / LRU_C)
        return jnp.log(a) - jnp.log1p(-a)

    nA, nB, nC, nD = uses(0), uses(1), uses(2), uses(3)
    beta = DEEPNORM_BETA
    inputs = {}
    inputs['x'] = nrm((BATCH, SEQ, D), 1.0)
    inputs['c'] = nrm((BATCH, D), 1.0)
    inputs['ctx'] = nrm((BATCH, CTX_LEN, D), 1.0)
    inputs['c_ctx'] = nrm((D,), 1.0)
    inputs['ada_w'] = nrm((DEPTH, D, ADA_CHUNKS * D), 0.5 * D ** -0.5)
    inputs['ada_b'] = nrm((DEPTH, ADA_CHUNKS * D), 0.02)
    inputs['ln_g'] = 1.0 + nrm((DEPTH, 2, D), 0.02)
    inputs['ln_b'] = nrm((DEPTH, 2, D), 0.02)
    inputs['mlp_w1'] = nrm((DEPTH, D, D_FF), D ** -0.5)
    inputs['mlp_w2'] = nrm((DEPTH, D_FF, D), beta * D_FF ** -0.5)
    inputs['lru_w_in'] = nrm((nA, D, 2 * LRU_WIDTH), D ** -0.5)
    inputs['lru_conv_w'] = nrm((nA, LRU_CONV_W, LRU_WIDTH), LRU_CONV_W ** -0.5)
    inputs['lru_conv_b'] = nrm((nA, LRU_WIDTH), 0.02)
    inputs['lru_gate_w'] = nrm((nA, 2, 2, LRU_BLOCKS, LRU_BLOCK_W, LRU_BLOCK_W), LRU_BLOCK_W ** -0.5)
    inputs['lru_gate_b'] = nrm((nA, 2, 2, LRU_WIDTH), 0.02)
    inputs['lru_lambda'] = lru_lambda_init((nA, 2, LRU_WIDTH))
    inputs['lru_w_out'] = nrm((nA, LRU_WIDTH, D), beta * LRU_WIDTH ** -0.5)
    inputs['dif_w_qkv'] = nrm((nB, D, 3 * DIF_HEADS * DIF_DV), D ** -0.5)
    inputs['dif_lambda'] = nrm((nB, 4, DIF_DH), 0.1)
    inputs['dif_subln'] = 1.0 + nrm((nB, DIF_DV), 0.02)
    inputs['dif_w_out'] = nrm((nB, DIF_HEADS * DIF_DV, D), beta * (DIF_HEADS * DIF_DV) ** -0.5)
    inputs['ret_w_qkvg'] = nrm((nC, D, 2 * D + 2 * RET_HEADS * RET_DV), D ** -0.5)
    inputs['ret_w_out'] = nrm((nC, RET_HEADS * RET_DV, D), beta * (RET_HEADS * RET_DV) ** -0.5)
    inputs['swa_w_qkv'] = nrm((nD, D, (SWA_HEADS + 2 * SWA_KV_HEADS) * SWA_DH), D ** -0.5)
    inputs['swa_sink'] = nrm((nD, SWA_HEADS), 0.5)
    inputs['swa_w_out'] = nrm((nD, SWA_HEADS * SWA_DH, D), beta * (SWA_HEADS * SWA_DH) ** -0.5)
    return inputs


def reference(x, c, ctx, c_ctx, ada_w, ada_b, ln_g, ln_b, mlp_w1, mlp_w2,
              lru_w_in, lru_conv_w, lru_conv_b, lru_gate_w, lru_gate_b, lru_lambda, lru_w_out,
              dif_w_qkv, dif_lambda, dif_subln, dif_w_out,
              ret_w_qkvg, ret_w_out,
              swa_w_qkv, swa_sink, swa_w_out):
    ROWS = x.shape[1] // GRID_W
    cos_d, sin_d = axial_rope_tables(ROWS, DIF_DH)
    cos_w, sin_w = axial_rope_tables(ROWS, SWA_DH)
    h = x
    hc = ctx
    for i in range(DEPTH):
        kind, j = i % N_MIXERS, i // N_MIXERS
        ctx_out = i < DEPTH - 1
        m = jax.nn.silu(c) @ ada_w[i] + ada_b[i]
        mc = jax.nn.silu(c_ctx) @ ada_w[i] + ada_b[i]
        sh1, sc1, g1, sh2, sc2, g2 = jnp.split(m[:, None, :], ADA_CHUNKS, -1)
        csh1, csc1, cg1, csh2, csc2, cg2 = jnp.split(mc, ADA_CHUNKS, -1)
        u_l = h * (1 + sc1) + sh1
        u_c = hc * (1 + csc1) + csh1
        if kind == 0:
            y_l, y_c = rglru_mixer(u_l, u_c, lru_w_in[j], lru_conv_w[j], lru_conv_b[j], lru_gate_w[j],
                                   lru_gate_b[j], lru_lambda[j], lru_w_out[j], ctx_out)
        elif kind == 1:
            y_l, y_c = diff_attention_mixer(u_l, u_c, dif_w_qkv[j], dif_lambda[j], dif_subln[j], dif_w_out[j],
                                            cos_d, sin_d, i, ctx_out)
        elif kind == 2:
            y_l, y_c = retention_mixer(u_l, u_c, ret_w_qkvg[j], ret_w_out[j], ctx_out)
        else:
            y_l, y_c = window_gqa_mixer(u_l, u_c, swa_w_qkv[j], swa_sink[j], swa_w_out[j], cos_w, sin_w, ctx_out)
        h = layer_norm(DEEPNORM_ALPHA * h + g1 * y_l, ln_g[i, 0], ln_b[i, 0])
        f_l = squared_relu_mlp(h * (1 + sc2) + sh2, mlp_w1[i], mlp_w2[i])
        h = layer_norm(DEEPNORM_ALPHA * h + g2 * f_l, ln_g[i, 1], ln_b[i, 1])
        if ctx_out:
            hc = layer_norm(DEEPNORM_ALPHA * hc + cg1 * y_c, ln_g[i, 0], ln_b[i, 0])
            f_c = squared_relu_mlp(hc * (1 + csc2) + csh2, mlp_w1[i], mlp_w2[i])
            hc = layer_norm(DEEPNORM_ALPHA * hc + cg2 * f_c, ln_g[i, 1], ln_b[i, 1])
    return h
```

```cpp
#include <hip/hip_runtime.h>
#include <cstdio>
#include <cstdint>

#ifndef MK_MULTI
#define MK_MULTI 0
#endif

#define LAS __attribute__((address_space(3)))
#define GAS __attribute__((address_space(1)))
typedef unsigned short bf16_t;
typedef short bf16x8 __attribute__((ext_vector_type(8)));
typedef float f32x4 __attribute__((ext_vector_type(4)));
typedef float f32x2 __attribute__((ext_vector_type(2)));
typedef float f32x16 __attribute__((ext_vector_type(16)));
typedef unsigned u32x4 __attribute__((ext_vector_type(4)));
typedef unsigned u32x2 __attribute__((ext_vector_type(2)));

constexpr int D = 2048, NB = 4, SEQ = 2048, CTX = 256, DEPTH = 4, FF = 8192;
constexpr int RL = NB * SEQ, RC = NB * CTX, R = RL + RC;
constexpr int NTOK = SEQ + CTX;
constexpr float LN_EPS = 1e-5f;
constexpr float ALPHA = 1.681792830507429f;
constexpr float LOG2E = 1.4426950408889634f;
constexpr int MODW = 6 * D;

constexpr size_t MiB = (size_t)1 << 20;
constexpr size_t WS_CTL = 0, CTL_BYTES = 1 * MiB;
constexpr size_t WS_MOD = 1 * MiB;
constexpr size_t WS_SP = 2 * MiB;
constexpr size_t WS_PART = 3 * MiB;
constexpr size_t WS_W = 11 * MiB;
constexpr size_t W_LRU_IN = WS_W, W_LRU_G = WS_W + 16 * MiB, W_LRU_OUT = WS_W + 20 * MiB, W_DIF_QKV = WS_W + 28 * MiB, W_DIF_OUT = WS_W + 52 * MiB,
                 W_RET_QKVG = WS_W + 60 * MiB, W_RET_OUT = WS_W + 108 * MiB, W_SWA_QKV = WS_W + 124 * MiB, W_SWA_OUT = WS_W + 136 * MiB,
                 W_MLP1 = WS_W + 144 * MiB, W_MLP2 = WS_W + 272 * MiB;
constexpr size_t WS_H = 411 * MiB, WS_T = 483 * MiB, WS_U = 555 * MiB, WS_X = 591 * MiB;
constexpr size_t X_ACT = WS_X;
constexpr size_t X_GG = WS_X, X_REC = WS_X + 36 * MiB, X_XCB = WS_X + 108 * MiB, X_XCF = WS_X + 144 * MiB, X_AB = WS_X + 216 * MiB, X_BB = WS_X + 360 * MiB,
                 X_CARRY = WS_X + 504 * MiB, X_YIN = WS_X + 512 * MiB;
constexpr size_t X_Q1 = WS_X, X_K1 = WS_X + 36 * MiB, X_VT1 = WS_X + 72 * MiB, X_OD = WS_X + 108 * MiB, X_DO = WS_X + 252 * MiB;
constexpr size_t X_Q2 = WS_X, X_K2 = WS_X + 36 * MiB, X_KTF = WS_X + 72 * MiB, X_KTB = WS_X + 108 * MiB, X_A3 = WS_X + 144 * MiB, X_B3 = WS_X + 252 * MiB,
                 X_KVT = WS_X + 468 * MiB, X_O2 = X_KVT, X_RO = WS_X, X_SG = WS_T;
constexpr size_t X_Q3 = WS_X, X_K3 = WS_X + 36 * MiB, X_VT3 = WS_X + 48 * MiB, X_AO = WS_X + 60 * MiB;
constexpr size_t WS_END = WS_X + 756 * MiB;

__device__ __forceinline__ unsigned cvt_pk_bf16(float lo, float hi) { unsigned r; asm volatile("v_cvt_pk_bf16_f32 %0, %1, %2" : "=v"(r) : "v"(lo), "v"(hi)); return r; }
__device__ __forceinline__ bf16_t f2bf(float x) { return (bf16_t)(cvt_pk_bf16(x, 0.f) & 0xffffu); }
__device__ __forceinline__ u32x2 pk4(f32x4 v) { u32x2 w; w.x = cvt_pk_bf16(v[0], v[1]); w.y = cvt_pk_bf16(v[2], v[3]); return w; }
__device__ __forceinline__ float bf2f(bf16_t u) { return __uint_as_float(((unsigned)u) << 16); }
__device__ __forceinline__ float ex2(float x) { return __builtin_amdgcn_exp2f(x); }
__device__ __forceinline__ float rcpf(float x) { return __builtin_amdgcn_rcpf(x); }
__device__ __forceinline__ float sigmoidf(float x) { return rcpf(1.f + ex2(-x * LOG2E)); }
__device__ __forceinline__ float siluf(float x) { return x * sigmoidf(x); }
__device__ __forceinline__ float gelu_tanh(float x) { const float z = 0.7978845608028654f * (x + 0.044715f * x * x * x); return x * rcpf(1.f + ex2(-2.f * LOG2E * z)); }
__device__ __forceinline__ int mod_row(int row) { return row < RL ? (row >> 11) : 4; }
__device__ __forceinline__ float wave_sum(float v) {
#pragma unroll
    for (int o = 1; o < 64; o <<= 1) v += __shfl_xor(v, o);
    return v;
}
__device__ __forceinline__ float ret_log2g(int h) {
    const float x = ex2(-5.f - (float)h);
    const float s = x * (1.f + x * (0.5f + x * (1.f / 3.f + x * (0.25f + x * (0.2f + x * (1.f / 6.f + x * (1.f / 7.f)))))));
    return -s * LOG2E;
}

namespace pg8 {
constexpr int BM = 256, BK = 64, HALF = 128, HTB = HALF * BK * 2, STAGE_BYTES = 8 * HTB, NXCD = 8, WGM = 8;
__host__ __device__ __forceinline__ int lds_byte(int r, int c) { const int st = (r >> 4) * 2 + (c >> 5), rr = r & 15, cc = c & 31, ob = rr * 64 + cc * 2; return st * 1024 + (ob ^ (((ob >> 9) & 1) << 5)); }
__host__ __device__ __forceinline__ void stage_rc(int b, int& Rr, int& C) { const int st = b / 1024, sb = b % 1024, swz = sb ^ (((sb >> 9) & 1) << 5); Rr = (st >> 1) * 16 + swz / 64; C = (st & 1) * 32 + (swz % 64) / 2; }

struct Unit { const char* a; const char* b; int pm, pn; };

template <class Map> struct Order {
    int nM, nN, nwg, G, c; Map map;
    __device__ __forceinline__ void init(int nM_, int nN_, int G_, int c_, const Map& m) { nM = nM_; nN = nN_; nwg = nM_ * nN_; G = G_; c = c_; map = m; }
    __device__ __forceinline__ bool next(int i, Unit& u) const {
        const long Lx = (long)i * G + c; if (Lx >= nwg) return false;
        int wgid = (int)Lx; { const int q = nwg / NXCD, r = nwg % NXCD, xcd = wgid % NXCD, off = wgid / NXCD; wgid = (xcd < r ? xcd * (q + 1) : r * (q + 1) + (xcd - r) * q) + off; }
        const int nig = WGM * nN, gid = wgid / nig, fm = gid * WGM, gsz = (nM - fm) < WGM ? (nM - fm) : WGM;
        u.pm = fm + ((wgid % nig) % gsz); u.pn = (wgid % nig) / gsz; map(u); return true;
    }
};

template <class Epi, class Sched, bool ALIGN_EPI>
__device__ __forceinline__ void gemm_phase(LAS unsigned char* lds, const int tid, const int K, const int lda, const int ldb, const Sched& S, const Epi& E) {
    const int wid = __builtin_amdgcn_readfirstlane(tid >> 6), lane = tid & 63, wr = wid >> 2, wc = wid & 3, fr = lane & 15, fq = lane >> 4;
    const int nt = K / BK;
    unsigned voffA[2], voffB[2];
#pragma unroll
    for (int i = 0; i < 2; ++i) { int Rr, C; stage_rc(tid * 16 + i * 8192, Rr, C); voffA[i] = (unsigned)(Rr * lda + C) * 2u; voffB[i] = (unsigned)(Rr * ldb + C) * 2u; }
    const size_t kstep = (size_t)(BK * 2);
    const size_t hstepA = (size_t)HALF * lda * 2, hstepB = (size_t)HALF * ldb * 2;
    const unsigned ldsw = (unsigned)wid * 1024u;
    const int aoff = lds_byte(wr * 64 + fr, fq * 8), boff = lds_byte(wc * 32 + fr, fq * 8);
#define PG8_SA(b, h) (((b) * 2 + (h)) * HTB)
#define PG8_SB(b, h) ((4 + (b) * 2 + (h)) * HTB)
#define PG8_STAGE(bufoff, gbase, voff) do { _Pragma("unroll") for (int _i = 0; _i < 2; ++_i) \
        __builtin_amdgcn_global_load_lds((const unsigned*)((const char*)(gbase) + (voff)[_i]), (LAS unsigned*)(lds + (bufoff) + ldsw + _i * 8192), 16, 0, 0); } while (0)
#define PG8_LDA(dst, b, h) do { _Pragma("unroll") for (int m = 0; m < 4; ++m) _Pragma("unroll") for (int k = 0; k < 2; ++k) dst[m][k] = *(const LAS bf16x8*)(lds + PG8_SA(b, h) + aoff + m * 2048 + k * 1024); } while (0)
#define PG8_LDB(dst, b, h) do { _Pragma("unroll") for (int n = 0; n < 2; ++n) _Pragma("unroll") for (int k = 0; k < 2; ++k) dst[n][k] = *(const LAS bf16x8*)(lds + PG8_SB(b, h) + boff + n * 2048 + k * 1024); } while (0)
#define PG8_MMA(ai, bj, At, Bt) do { __builtin_amdgcn_s_setprio(1); _Pragma("unroll") for (int m = 0; m < 4; ++m) _Pragma("unroll") for (int n = 0; n < 2; ++n) _Pragma("unroll") for (int k = 0; k < 2; ++k) \
        acc[ai][bj][m][n] = __builtin_amdgcn_mfma_f32_16x16x32_bf16(Bt[n][k], At[m][k], acc[ai][bj][m][n], 0, 0, 0); __builtin_amdgcn_s_setprio(0); } while (0)
#define PG8_WAIT_V(n) asm volatile("s_waitcnt vmcnt(" #n ")" ::: "memory")
#define PG8_WAIT_L(n) asm volatile("s_waitcnt lgkmcnt(" #n ")" ::: "memory")
#define PG8_BAR __builtin_amdgcn_s_barrier()
#define PG8_SCHED __builtin_amdgcn_sched_barrier(0)
    Unit cur, nxt; int ui = 0;
    if (!S.next(0, cur)) return;
    f32x4 acc[2][2][4][2];
#pragma unroll
    for (int a = 0; a < 2; ++a)
#pragma unroll
        for (int b = 0; b < 2; ++b)
#pragma unroll
            for (int m = 0; m < 4; ++m)
#pragma unroll
                for (int n = 0; n < 2; ++n) acc[a][b][m][n] = (f32x4){0.f, 0.f, 0.f, 0.f};
    bf16x8 At[4][2], B0[2][2], B1[2][2];
    const char* cA = cur.a; const char* cB = cur.b;
    PG8_STAGE(PG8_SB(0, 0), cB, voffB); PG8_STAGE(PG8_SB(0, 1), cB + hstepB, voffB); PG8_STAGE(PG8_SA(0, 0), cA, voffA); PG8_STAGE(PG8_SA(0, 1), cA + hstepA, voffA);
    if (wr == 1) PG8_BAR;
    PG8_WAIT_V(2); PG8_BAR;
    PG8_STAGE(PG8_SB(1, 0), cB + kstep, voffB); PG8_STAGE(PG8_SA(1, 0), cA + kstep, voffA); PG8_STAGE(PG8_SB(1, 1), cB + hstepB + kstep, voffB);
    PG8_WAIT_V(6); PG8_BAR;
#pragma unroll 1
    for (;;) {
        const bool has_next = S.next(ui + 1, nxt);
        const char* nA = has_next ? nxt.a : cA; const char* nB = has_next ? nxt.b : cB;
#pragma unroll 1
        for (int t = 0; t < nt; t += 2) {
            const bool last = (t == nt - 2);
            const char* a1 = cA + (size_t)(t + 1) * kstep;
            const char* a2 = last ? nA : cA + (size_t)(t + 2) * kstep; const char* b2 = last ? nB : cB + (size_t)(t + 2) * kstep;
            const char* a3 = a2 + kstep; const char* b3 = b2 + kstep;
            PG8_LDB(B0, 0, 0); PG8_LDB(B1, 0, 1); PG8_SCHED; PG8_LDA(At, 0, 0); PG8_STAGE(PG8_SA(1, 1), a1 + hstepA, voffA);
            PG8_WAIT_V(8); PG8_WAIT_L(0); PG8_BAR; PG8_MMA(0, 0, At, B0); PG8_MMA(0, 1, At, B1); PG8_BAR; PG8_SCHED;
            PG8_LDA(At, 0, 1); PG8_STAGE(PG8_SB(0, 0), b2, voffB); PG8_STAGE(PG8_SB(0, 1), b2 + hstepB, voffB); PG8_STAGE(PG8_SA(0, 0), a2, voffA);
            PG8_WAIT_V(8); PG8_WAIT_L(0); PG8_BAR; PG8_MMA(1, 0, At, B0); PG8_MMA(1, 1, At, B1); PG8_BAR; PG8_SCHED;
            PG8_LDB(B0, 1, 0); PG8_LDB(B1, 1, 1); PG8_SCHED; PG8_LDA(At, 1, 0); PG8_STAGE(PG8_SA(0, 1), a2 + hstepA, voffA);
            PG8_WAIT_V(8); PG8_WAIT_L(0); PG8_BAR; PG8_MMA(0, 0, At, B0); PG8_MMA(0, 1, At, B1); PG8_BAR; PG8_SCHED;
            PG8_LDA(At, 1, 1); PG8_STAGE(PG8_SB(1, 0), b3, voffB); PG8_STAGE(PG8_SB(1, 1), b3 + hstepB, voffB); PG8_STAGE(PG8_SA(1, 0), a3, voffA);
            PG8_WAIT_V(8); PG8_WAIT_L(0); PG8_BAR; PG8_MMA(1, 0, At, B0); PG8_MMA(1, 1, At, B1); PG8_BAR; PG8_SCHED;
        }
        if constexpr (ALIGN_EPI) { if (wr == 0) PG8_BAR; }
        { int efr = fr, efq = fq, ewr = wr, ewc = wc; asm volatile("" : "+v"(efr), "+v"(efq), "+s"(ewr), "+s"(ewc));
          E(acc, cur, ewr, ewc, efr, efq); }
        if (!has_next) break;
#pragma unroll
        for (int a = 0; a < 2; ++a)
#pragma unroll
            for (int b = 0; b < 2; ++b)
#pragma unroll
                for (int m = 0; m < 4; ++m)
#pragma unroll
                    for (int n = 0; n < 2; ++n) acc[a][b][m][n] = (f32x4){0.f, 0.f, 0.f, 0.f};
        cur = nxt; cA = nA; cB = nB; ++ui;
        if constexpr (ALIGN_EPI) { if (wr == 1) PG8_BAR; }
    }
    PG8_WAIT_V(0);
    if constexpr (!ALIGN_EPI) { if (wr == 0) PG8_BAR; }
    PG8_BAR;
#undef PG8_SA
#undef PG8_SB
#undef PG8_STAGE
#undef PG8_LDA
#undef PG8_LDB
#undef PG8_MMA
#undef PG8_WAIT_V
#undef PG8_WAIT_L
#undef PG8_BAR
#undef PG8_SCHED
}
}
using pg8::Unit;
typedef f32x4 Acc[2][2][4][2];
#define EPI_ROWS(ai, m) _Pragma("unroll") for (int ai = 0; ai < 2; ++ai) _Pragma("unroll") for (int m = 0; m < 4; ++m)
#define EPI_COLS(bj, n) _Pragma("unroll") for (int bj = 0; bj < 2; ++bj) _Pragma("unroll") for (int n = 0; n < 2; ++n)

struct MapPlain { const char* A; const char* B; size_t astep, bstep;
    __device__ __forceinline__ void operator()(Unit& u) const { u.a = A + (size_t)u.pm * astep; u.b = B + (size_t)u.pn * bstep; } };
struct MapLruGate { const char* XC; const char* WG;
    __device__ __forceinline__ void operator()(Unit& u) const { const int blk = (u.pn >> 1) & 7; u.a = XC + ((size_t)u.pm * 256 * D + blk * 256) * 2; u.b = WG + (size_t)u.pn * 256 * 256 * 2; } };
struct MapRetS { const char* Q; const char* Kk;
    __device__ __forceinline__ void operator()(Unit& u) const { const size_t o = ((size_t)u.pm * 256 * D + u.pn * 256) * 2; u.a = Q + o; u.b = Kk + o; } };
struct MapRetKV { const char* B3; const char* KTf; const char* KTb;
    __device__ __forceinline__ void operator()(Unit& u) const { const int half = u.pn & 1, dir = (u.pn >> 1) & 1, h = u.pn >> 2; const size_t ph = (size_t)u.pm * 8 + h;
        u.a = B3 + ((ph * 512 + half * 256) * 768 + 512) * 2; u.b = (dir ? KTb : KTf) + ph * 256 * 256 * 2; } };
struct MapRetOut { const char* A3; const char* B3;
    __device__ __forceinline__ void operator()(Unit& u) const { const int half = u.pn & 1, h = u.pn >> 1; const size_t ph = (size_t)u.pm * 8 + h;
        u.a = A3 + ((size_t)u.pm * 256 * 8 + h) * 768 * 2; u.b = B3 + (ph * 512 + half * 256) * 768 * 2; } };

struct EpiResid {
    const float* H; float* T; const float* gate;
    __device__ __forceinline__ void operator()(const Acc& acc, const Unit& u, int wr, int wc, int fr, int fq) const {
        EPI_ROWS(ai, m) { const int row = u.pm * 256 + ai * 128 + wr * 64 + m * 16 + fr; const float* gp = gate + (size_t)mod_row(row) * MODW;
            EPI_COLS(bj, n) { const int col = u.pn * 256 + bj * 128 + wc * 32 + n * 16 + fq * 4; const size_t o = (size_t)row * D + col;
                const f32x4 h = *(const f32x4*)(H + o), g = *(const f32x4*)(gp + col); *(f32x4*)(T + o) = h * ALPHA + g * acc[ai][bj][m][n]; }
            asm volatile("" ::: "memory"); }
    }
};
struct EpiMlpUp {
    bf16_t* O;
    __device__ __forceinline__ void operator()(const Acc& acc, const Unit& u, int wr, int wc, int fr, int fq) const {
        EPI_ROWS(ai, m) { const int row = u.pm * 256 + ai * 128 + wr * 64 + m * 16 + fr;
            EPI_COLS(bj, n) { const int col = u.pn * 256 + bj * 128 + wc * 32 + n * 16 + fq * 4; f32x4 v = acc[ai][bj][m][n];
#pragma unroll
                for (int j = 0; j < 4; ++j) { const float r = fmaxf(v[j], 0.f); v[j] = r * r; }
                *(u32x2*)(O + (size_t)row * FF + col) = pk4(v); } }
    }
};
struct EpiLruIn {
    bf16_t* GG; float* REC;
    __device__ __forceinline__ void operator()(const Acc& acc, const Unit& u, int wr, int wc, int fr, int fq) const {
        const bool isg = u.pn < 8;
        EPI_ROWS(ai, m) { const int row = u.pm * 256 + ai * 128 + wr * 64 + m * 16 + fr;
            EPI_COLS(bj, n) { const int col = (u.pn & 7) * 256 + bj * 128 + wc * 32 + n * 16 + fq * 4; f32x4 v = acc[ai][bj][m][n];
                if (isg) {
#pragma unroll
                    for (int j = 0; j < 4; ++j) v[j] = gelu_tanh(v[j]);
                    *(u32x2*)(GG + (size_t)row * D + col) = pk4(v);
                } else *(f32x4*)(REC + (size_t)row * D + col) = v; } }
    }
};
struct EpiLruGate {
    const float* XCF; const float* gb; const float* SP; float* AB; float* BB;
    __device__ __forceinline__ void operator()(const Acc& acc, const Unit& u, int wr, int wc, int fr, int fq) const {
        const int half = u.pn & 1, blk = (u.pn >> 1) & 7, dir = u.pn >> 4;
        EPI_ROWS(ai, m) { const int row = u.pm * 256 + ai * 128 + wr * 64 + m * 16 + fr;
#pragma unroll
            for (int n = 0; n < 2; ++n) { const int ch = blk * 256 + half * 128 + wc * 32 + n * 16 + fq * 4;
                const f32x4 br = *(const f32x4*)(gb + (dir * 2 + 0) * D + ch), bi = *(const f32x4*)(gb + (dir * 2 + 1) * D + ch), sp = *(const f32x4*)(SP + dir * D + ch);
                const f32x4 xc = *(const f32x4*)(XCF + (size_t)row * D + ch); const f32x4 rp = acc[ai][0][m][n] + br, ip = acc[ai][1][m][n] + bi; f32x4 av, bv;
#pragma unroll
                for (int j = 0; j < 4; ++j) { const float r = sigmoidf(rp[j]), ig = sigmoidf(ip[j]); const float la = sp[j] * r; const float a = ex2(la * LOG2E); const float y = 2.f * la;
                    const float om = (y > -0.1f) ? -(y * (1.f + y * (0.5f + y * (1.f / 6.f + y * (1.f / 24.f + y * (1.f / 120.f)))))) : (1.f - ex2(y * LOG2E));
                    av[j] = a; bv[j] = sqrtf(fmaxf(om, 0.f)) * ig * xc[j]; }
                const size_t o = ((size_t)dir * R + row) * D + ch; *(f32x4*)(AB + o) = av; *(f32x4*)(BB + o) = bv; }
            asm volatile("" ::: "memory"); }
    }
};
struct EpiQKV {
    bf16_t* Q; bf16_t* K; bf16_t* VT; int kcols, vshift, vheads;
    __device__ __forceinline__ void operator()(const Acc& acc, const Unit& u, int wr, int wc, int fr, int fq) const {
        const int col0 = u.pn * 256; const int type = col0 < D ? 0 : (col0 < D + kcols ? 1 : 2);
        if (type < 2) {
            float revf[4];
#pragma unroll
            for (int j = 0; j < 4; ++j) revf[j] = ex2(-(float)(fq * 4 + j) * (13.287712379549449f / 16.f)) * 0.15915494309189535f;
            const float qs = type == 0 ? 0.125f * LOG2E : 1.f;
            EPI_ROWS(ai, m) { const int row = u.pm * 256 + ai * 128 + wr * 64 + m * 16 + fr; const bool lat = row < RL; const int t = row & (SEQ - 1);
                const float pos = (wc & 1) ? (float)(t & 63) : (float)(t >> 6);
                float cs[4], sn[4];
#pragma unroll
                for (int j = 0; j < 4; ++j) { const float rv = pos * revf[j]; cs[j] = lat ? __builtin_amdgcn_cosf(rv) : 1.f; sn[j] = lat ? __builtin_amdgcn_sinf(rv) : 0.f; }
#pragma unroll
                for (int bj = 0; bj < 2; ++bj) { const f32x4 x0 = acc[ai][bj][m][0], x1 = acc[ai][bj][m][1]; f32x4 y0, y1;
#pragma unroll
                    for (int j = 0; j < 4; ++j) { y0[j] = (x0[j] * cs[j] - x1[j] * sn[j]) * qs; y1[j] = (x1[j] * cs[j] + x0[j] * sn[j]) * qs; }
                    const int col = col0 + bj * 128 + wc * 32 + fq * 4;
                    if (type == 0) { bf16_t* p = Q + (size_t)row * D + col; *(u32x2*)p = pk4(y0); *(u32x2*)(p + 16) = pk4(y1); }
                    else { bf16_t* p = K + (size_t)row * kcols + (col - D); *(u32x2*)p = pk4(y0); *(u32x2*)(p + 16) = pk4(y1); } } }
        } else {
            EPI_ROWS(ai, m) { const int row = u.pm * 256 + ai * 128 + wr * 64 + m * 16 + fr; const bool lat = row < RL;
                const int b = lat ? (row >> 11) : ((row - RL) >> 8), tk = lat ? (row & (SEQ - 1)) : (SEQ + ((row - RL) & (CTX - 1)));
                EPI_COLS(bj, n) { const int vc = col0 - D - kcols + bj * 128 + wc * 32 + n * 16 + fq * 4; const int hh = vc >> vshift, e = vc & ((1 << vshift) - 1);
                    bf16_t* p = VT + ((size_t)(b * vheads + hh) * (1 << vshift) + e) * NTOK + tk; const f32x4 v = acc[ai][bj][m][n];
#pragma unroll
                    for (int j = 0; j < 4; ++j) p[(size_t)j * NTOK] = f2bf(v[j]); } }
        }
    }
};
struct EpiRetQKVG {
    bf16_t* Q2; bf16_t* K2; bf16_t* KTf; bf16_t* KTb; bf16_t* A3; bf16_t* B3; bf16_t* SG;
    __device__ __forceinline__ void operator()(const Acc& acc, const Unit& u, int wr, int wc, int fr, int fq) const {
        const int pn = u.pn;
        if (pn < 8) { const int h = pn; const float lgf = ret_log2g(h), lgb = ret_log2g(7 - h);
            EPI_ROWS(ai, m) { const int pos = ai * 128 + wr * 64 + m * 16 + fr; const int row = u.pm * 256 + pos; const float df = ex2((float)(pos + 1) * lgf), db = ex2((float)(256 - pos) * lgb);
                EPI_COLS(bj, n) { const int d = bj * 128 + wc * 32 + n * 16 + fq * 4; const f32x4 q = acc[ai][bj][m][n] * 0.0625f;
                    *(u32x2*)(Q2 + (size_t)row * D + h * 256 + d) = pk4(q); bf16_t* ap = A3 + ((size_t)row * 8 + h) * 768 + d;
                    *(u32x2*)ap = pk4(q * df); *(u32x2*)(ap + 256) = pk4(q * db); } }
        } else if (pn < 16) { const int h = pn - 8; const float lgf = ret_log2g(h), lgb = ret_log2g(7 - h);
            EPI_ROWS(ai, m) { const int pos = ai * 128 + wr * 64 + m * 16 + fr; const int row = u.pm * 256 + pos; const float df = ex2((float)(255 - pos) * lgf), db = ex2((float)pos * lgb);
                EPI_COLS(bj, n) { const int d = bj * 128 + wc * 32 + n * 16 + fq * 4; const f32x4 k = acc[ai][bj][m][n];
                    *(u32x2*)(K2 + (size_t)row * D + h * 256 + d) = pk4(k); const size_t to = (((size_t)u.pm * 8 + h) * 256 + d) * 256 + pos;
#pragma unroll
                    for (int j = 0; j < 4; ++j) { KTf[to + j * 256] = f2bf(k[j] * df); KTb[to + j * 256] = f2bf(k[j] * db); } } }
        } else if (pn < 32) { const int h = (pn - 16) >> 1, half = (pn - 16) & 1;
            EPI_ROWS(ai, m) { const int pos = ai * 128 + wr * 64 + m * 16 + fr;
                EPI_COLS(bj, n) { const int e = half * 256 + bj * 128 + wc * 32 + n * 16 + fq * 4; const f32x4 v = acc[ai][bj][m][n];
                    bf16_t* p = B3 + (((size_t)u.pm * 8 + h) * 512 + e) * 768 + 512 + pos;
#pragma unroll
                    for (int j = 0; j < 4; ++j) p[j * 768] = f2bf(v[j]); } }
        } else {
            EPI_ROWS(ai, m) { const int row = u.pm * 256 + ai * 128 + wr * 64 + m * 16 + fr;
                EPI_COLS(bj, n) { const int col = (pn - 32) * 256 + bj * 128 + wc * 32 + n * 16 + fq * 4; f32x4 v = acc[ai][bj][m][n];
#pragma unroll
                    for (int j = 0; j < 4; ++j) v[j] = siluf(v[j]);
                    *(u32x2*)(SG + (size_t)row * 4096 + col) = pk4(v); } }
        }
    }
};
struct EpiRetS {
    bf16_t* A3;
    __device__ __forceinline__ void operator()(const Acc& acc, const Unit& u, int wr, int wc, int fr, int fq) const {
        const int h = u.pn; const float lgf = ret_log2g(h), lgb = ret_log2g(7 - h);
        EPI_ROWS(ai, m) { const int i = ai * 128 + wr * 64 + m * 16 + fr; const int row = u.pm * 256 + i;
            EPI_COLS(bj, n) { const int j0 = bj * 128 + wc * 32 + n * 16 + fq * 4; f32x4 v = acc[ai][bj][m][n];
#pragma unroll
                for (int j = 0; j < 4; ++j) { const int rel = i - (j0 + j); v[j] *= rel >= 0 ? ex2((float)rel * lgf) : ex2((float)(-rel) * lgb); }
                *(u32x2*)(A3 + ((size_t)row * 8 + h) * 768 + 512 + j0) = pk4(v); } }
    }
};
struct EpiRetKV {
    float* KVT;
    __device__ __forceinline__ void operator()(const Acc& acc, const Unit& u, int wr, int wc, int fr, int fq) const {
        const int half = u.pn & 1, hd = u.pn >> 1;
        float* base = KVT + (((size_t)u.pm * 16 + hd) * 512 + half * 256) * 256;
        EPI_ROWS(ai, m) { const int r = ai * 128 + wr * 64 + m * 16 + fr;
            EPI_COLS(bj, n) { const int c = bj * 128 + wc * 32 + n * 16 + fq * 4; *(f32x4*)(base + (size_t)r * 256 + c) = acc[ai][bj][m][n]; } }
    }
};
struct EpiRetOut {
    float* O2;
    __device__ __forceinline__ void operator()(const Acc& acc, const Unit& u, int wr, int wc, int fr, int fq) const {
        EPI_ROWS(ai, m) { const int row = u.pm * 256 + ai * 128 + wr * 64 + m * 16 + fr;
            EPI_COLS(bj, n) { const int c = u.pn * 256 + bj * 128 + wc * 32 + n * 16 + fq * 4; *(f32x4*)(O2 + (size_t)row * 4096 + c) = acc[ai][bj][m][n]; } }
    }
};

template <int DV, bool OUTBF>
__device__ __forceinline__ void attn_unit(LAS unsigned char* lds, const int tid, const bf16_t* q, int ldq, const bf16_t* k0, const bf16_t* k1, int ldk,
                                          const bf16_t* vt0, const bf16_t* vt1, int ldvt, int nt0, int nt1, bool band, int qpos0, int kpos0,
                                          bool has_sink, float sink_l2, void* o, int ldo) {
    constexpr int KT_BYTES = 64 * 144, VT_BYTES = DV * 136, BUF = KT_BYTES + VT_BYTES, NV = DV / 64, NDV = DV / 32;
    const int lane = tid & 63, w = tid >> 6, c32 = lane & 31, hi = lane >> 5, srow = tid >> 3, sch = tid & 7;
    bf16x8 qf[4];
#pragma unroll
    for (int ks = 0; ks < 4; ++ks) qf[ks] = *(const bf16x8*)(q + (size_t)(32 * w + c32) * ldq + ks * 16 + hi * 8);
    f32x16 oacc[NDV];
#pragma unroll
    for (int i = 0; i < NDV; ++i)
#pragma unroll
        for (int r = 0; r < 16; ++r) oacc[i][r] = 0.f;
    float m_run = -1e30f, l_run = 0.f;
    const int ntile = nt0 + nt1;
    u32x4 kreg, vreg[NV];
    { const bf16_t* kp = nt0 > 0 ? k0 : k1; const bf16_t* vp = nt0 > 0 ? vt0 : vt1;
      kreg = *(const u32x4*)(kp + (size_t)srow * ldk + sch * 8);
#pragma unroll
      for (int i = 0; i < NV; ++i) vreg[i] = *(const u32x4*)(vp + (size_t)(srow + 64 * i) * ldvt + sch * 8); }
#pragma unroll 1
    for (int t = 0; t < ntile; ++t) {
        LAS unsigned char* kb = lds + (t & 1) * BUF; LAS unsigned char* vb = kb + KT_BYTES;
        *(LAS u32x4*)(kb + srow * 144 + sch * 16) = kreg;
#pragma unroll
        for (int i = 0; i < NV; ++i) { LAS unsigned char* p = vb + (srow + 64 * i) * 136 + sch * 16; *(LAS u32x2*)p = (u32x2){vreg[i].x, vreg[i].y}; *(LAS u32x2*)(p + 8) = (u32x2){vreg[i].z, vreg[i].w}; }
        __syncthreads();
        if (t + 1 < ntile) { const int t1 = t + 1; const bf16_t* kp = t1 < nt0 ? k0 + (size_t)(t1 * 64) * ldk : k1 + (size_t)((t1 - nt0) * 64) * ldk;
            const bf16_t* vp = t1 < nt0 ? vt0 + t1 * 64 : vt1 + (t1 - nt0) * 64;
            kreg = *(const u32x4*)(kp + (size_t)srow * ldk + sch * 8);
#pragma unroll
            for (int i = 0; i < NV; ++i) vreg[i] = *(const u32x4*)(vp + (size_t)(srow + 64 * i) * ldvt + sch * 8); }
        f32x16 sacc[2];
#pragma unroll
        for (int a = 0; a < 2; ++a) {
#pragma unroll
            for (int r = 0; r < 16; ++r) sacc[a][r] = 0.f;
#pragma unroll
            for (int ks = 0; ks < 4; ++ks) { const bf16x8 kf = *(const LAS bf16x8*)(kb + (32 * a + c32) * 144 + ks * 32 + hi * 16); sacc[a] = __builtin_amdgcn_mfma_f32_32x32x16_bf16(kf, qf[ks], sacc[a], 0, 0, 0); }
        }
        if (band && t < nt0) { const int qp = qpos0 + 32 * w + c32;
#pragma unroll
            for (int a = 0; a < 2; ++a)
#pragma unroll
                for (int r = 0; r < 16; ++r) { const int kp = kpos0 + t * 64 + 32 * a + (r & 3) + 8 * (r >> 2) + 4 * hi; const int dlt = kp - qp; if (dlt > 128 || dlt < -128) sacc[a][r] = -INFINITY; } }
        float mx = -INFINITY;
#pragma unroll
        for (int a = 0; a < 2; ++a)
#pragma unroll
            for (int r = 0; r < 16; ++r) mx = fmaxf(mx, sacc[a][r]);
        mx = fmaxf(mx, __shfl_xor(mx, 32));
        const float mnew = fmaxf(m_run, mx), alpha = ex2(m_run - mnew); m_run = mnew;
        float ls = 0.f;
#pragma unroll
        for (int a = 0; a < 2; ++a)
#pragma unroll
            for (int r = 0; r < 16; ++r) { const float p = ex2(sacc[a][r] - mnew); sacc[a][r] = p; ls += p; }
        l_run = l_run * alpha + ls;
#pragma unroll
        for (int i = 0; i < NDV; ++i)
#pragma unroll
            for (int r = 0; r < 16; ++r) oacc[i][r] *= alpha;
        bf16x8 pf[4];
#pragma unroll
        for (int a = 0; a < 2; ++a)
#pragma unroll
            for (int jj = 0; jj < 2; ++jj) { u32x4 wv; wv.x = cvt_pk_bf16(sacc[a][8 * jj + 0], sacc[a][8 * jj + 1]); wv.y = cvt_pk_bf16(sacc[a][8 * jj + 2], sacc[a][8 * jj + 3]);
                wv.z = cvt_pk_bf16(sacc[a][8 * jj + 4], sacc[a][8 * jj + 5]); wv.w = cvt_pk_bf16(sacc[a][8 * jj + 6], sacc[a][8 * jj + 7]); pf[2 * a + jj] = __builtin_bit_cast(bf16x8, wv); }
#pragma unroll
        for (int i = 0; i < NDV; ++i)
#pragma unroll
            for (int j = 0; j < 4; ++j) { const LAS unsigned char* p = vb + (32 * i + c32) * 136 + (16 * j + 4 * hi) * 2; const u32x2 lo = *(const LAS u32x2*)p, hh = *(const LAS u32x2*)(p + 16);
                const u32x4 wv = (u32x4){lo.x, lo.y, hh.x, hh.y}; oacc[i] = __builtin_amdgcn_mfma_f32_32x32x16_bf16(__builtin_bit_cast(bf16x8, wv), pf[j], oacc[i], 0, 0, 0); }
    }
    float lt = l_run + __shfl_xor(l_run, 32);
    if (has_sink) lt += ex2(sink_l2 - m_run);
    const float inv = 1.f / lt;
    const int row = 32 * w + c32;
#pragma unroll
    for (int i = 0; i < NDV; ++i)
#pragma unroll
        for (int g = 0; g < 4; ++g) { const int col = 32 * i + 8 * g + 4 * hi; const f32x4 v = (f32x4){oacc[i][4 * g], oacc[i][4 * g + 1], oacc[i][4 * g + 2], oacc[i][4 * g + 3]} * inv;
            if (OUTBF) *(u32x2*)((bf16_t*)o + (size_t)row * ldo + col) = pk4(v); else *(f32x4*)((float*)o + (size_t)row * ldo + col) = v; }
    __syncthreads();
}

#define XB_TMO      128
#define XB_XCNT(j)  (256  + 64 * (j))
#define XB_XSUB(j)  (1280 + 64 * (j))
#define XB_XGEN(j)  (2304 + 64 * (j))
#define XB_TOP      3328
#define XB_TOPGEN   3392
#define XCD_BAR_WORDS 3456
#define XB_SPIN_CAP (1u << 18)
__device__ __forceinline__ unsigned xb_ld(unsigned* p)              { return __hip_atomic_load(p, __ATOMIC_RELAXED, __HIP_MEMORY_SCOPE_AGENT); }
__device__ __forceinline__ unsigned xb_add(unsigned* p, unsigned v) { return __hip_atomic_fetch_add(p, v, __ATOMIC_RELAXED, __HIP_MEMORY_SCOPE_AGENT); }
__device__ __forceinline__ unsigned xb_xcc_id() { return (unsigned)__builtin_amdgcn_s_getreg((3 << 11) | 20) & 0xFu; }
#define XB_SPIN(cond, bar) do { unsigned _sp = 0; while (cond) { __builtin_amdgcn_s_sleep(1); \
    if ((++_sp & 255u) == 0u) { if (xb_ld(&(bar)[XB_TMO])) break; if (_sp > XB_SPIN_CAP) { atomicAdd(&(bar)[XB_TMO], 1u); break; } } } } while (0)
struct XcdBarrier { unsigned* bar; unsigned x; volatile LAS unsigned* st; };
__device__ __forceinline__ XcdBarrier xcd_barrier_post(unsigned* bar, volatile LAS unsigned* st) {
    XcdBarrier b; b.bar = bar; b.x = xb_xcc_id(); b.st = st;
    if (threadIdx.x == 0) (void)xb_add(&bar[XB_XCNT(b.x)], 1u);
    return b;
}
__device__ __forceinline__ void xcd_barrier_complete(unsigned* bar, unsigned x, unsigned& nloc, unsigned& nx) {
    const unsigned G = gridDim.x * gridDim.y * gridDim.z;
    unsigned sum, cnt, mine, sp = 0u;
    for (;;) {
        sum = 0u; cnt = 0u; mine = 0u;
#pragma unroll
        for (unsigned j = 0; j < 16; ++j) { const unsigned c = xb_ld(&bar[XB_XCNT(j)]); sum += c; cnt += (c > 0u) ? 1u : 0u; mine = (j == x) ? c : mine; }
        if (sum == G) break;
        __builtin_amdgcn_s_sleep(1);
        if ((++sp & 255u) == 0u) { if (xb_ld(&bar[XB_TMO])) break; if (sp > XB_SPIN_CAP) { atomicAdd(&bar[XB_TMO], 1u); break; } }
    }
    nloc = mine > 0u ? mine : 1u; nx = cnt > 0u ? cnt : 1u;
}
__device__ __forceinline__ void xcd_barrier(const XcdBarrier& b) {
    asm volatile("s_waitcnt vmcnt(0)" ::: "memory");
    __syncthreads();
    if (threadIdx.x == 0) {
        unsigned* bar = b.bar;
        __builtin_amdgcn_s_waitcnt(0);
        unsigned nloc = b.st[0], nx = b.st[1];
        if (nloc == 0u) { xcd_barrier_complete(bar, b.x, nloc, nx); b.st[0] = nloc; b.st[1] = nx; }
        const unsigned old = xb_add(&bar[XB_XSUB(b.x)], 1u);
        const unsigned gen = old / nloc;
        if (old + 1u == (gen + 1u) * nloc) {
            __builtin_amdgcn_fence(__ATOMIC_RELEASE, "agent");
            asm volatile("s_waitcnt vmcnt(0)" ::: "memory");
            const unsigned og = xb_add(&bar[XB_TOP], 1u);
            const unsigned tg = og / nx;
            if (og + 1u == (tg + 1u) * nx) xb_add(&bar[XB_TOPGEN], 1u);
            else XB_SPIN(xb_ld(&bar[XB_TOPGEN]) == tg, bar);
            __builtin_amdgcn_fence(__ATOMIC_ACQUIRE, "agent");
            xb_add(&bar[XB_XGEN(b.x)], 1u);
            asm volatile("s_waitcnt vmcnt(0)" ::: "memory");
        } else {
            XB_SPIN(xb_ld(&bar[XB_XGEN(b.x)]) == gen, bar);
            __builtin_amdgcn_fence(__ATOMIC_ACQUIRE, "agent");
            asm volatile("s_waitcnt vmcnt(0)" ::: "memory");
        }
    }
    __syncthreads();
}

constexpr int NWAVES = 8, NTHR = 512;
constexpr int RING_BYTES = 131072, MISC_OFF = RING_BYTES + 320, LDS_BYTES = 147456;
constexpr int CW_BAR = 4096;
constexpr int NPHASE = 3 + 12 * DEPTH;

struct Args { const float* in[26]; float* out; unsigned char* ws; int ph_lo, ph_hi; };
enum { I_X = 0, I_C, I_CTX, I_CCTX, I_ADAW, I_ADAB, I_LNG, I_LNB, I_W1, I_W2, I_LIN, I_LCW, I_LCB, I_LGW, I_LGB, I_LLAM, I_LOUT, I_DQKV, I_DLAM, I_DSUB, I_DOUT, I_RQKVG, I_ROUT, I_SQKV, I_SSINK, I_SOUT };

__device__ __forceinline__ unsigned pk2(float lo, float hi) { return cvt_pk_bf16(lo, hi); }
__device__ __forceinline__ void tr_item(const float* W, int ldw, bf16_t* WT, int ldt, int k0, int n0, LAS float* scr, int lane) {
#pragma unroll 8
    for (int i = 0; i < 32; ++i) { const int kk = 2 * i + (lane >> 5); scr[kk * 33 + (lane & 31)] = W[(size_t)(k0 + kk) * ldw + n0 + (lane & 31)]; }
    asm volatile("s_waitcnt lgkmcnt(0)" ::: "memory");
    const int c = lane & 7;
#pragma unroll
    for (int j = 0; j < 4; ++j) { const int n = (lane >> 3) + 8 * j; const LAS float* s = scr + (8 * c) * 33 + n;
        u32x4 o; o.x = pk2(s[0 * 33], s[1 * 33]); o.y = pk2(s[2 * 33], s[3 * 33]); o.z = pk2(s[4 * 33], s[5 * 33]); o.w = pk2(s[6 * 33], s[7 * 33]);
        *(u32x4*)(WT + (size_t)(n0 + n) * ldt + k0 + 8 * c) = o; }
    asm volatile("s_waitcnt lgkmcnt(0)" ::: "memory");
}
__device__ __forceinline__ void tr_job(const float* W, int K, int N, bf16_t* WT, LAS float* scr, int lane, int gw, int NGW, int& base) {
    const int nblk = N / 32, nitems = (K / 64) * nblk;
    for (int it = ((gw - base) % NGW + NGW) % NGW; it < nitems; it += NGW) tr_item(W, N, WT, K, 64 * (it / nblk), 32 * (it % nblk), scr, lane);
    base += nitems;
}

__device__ __forceinline__ unsigned char* launder_ptr(unsigned char* p) { unsigned long long w = (unsigned long long)p; unsigned l = (unsigned)w, h = (unsigned)(w >> 32);
    asm volatile("" : "+v"(l), "+v"(h)); l = __builtin_amdgcn_readfirstlane(l); h = __builtin_amdgcn_readfirstlane(h); return (unsigned char*)(((unsigned long long)h << 32) | l); }
__device__ __forceinline__ const float* input_ptr(const Args& a, int k) { asm volatile("" : "+v"(k)); k = __builtin_amdgcn_readfirstlane(k); return a.in[k]; }
#define PHFN __device__ __forceinline__
PHFN void ph_lru_in(LAS unsigned char* lds, const int tid, unsigned char* ws, int G, int bid) {
    pg8::Order<MapPlain> S; S.init(R / 256, 16, G, bid, MapPlain{(const char*)(ws + WS_U), (const char*)(ws + W_LRU_IN), (size_t)256 * D * 2, (size_t)256 * D * 2});
    EpiLruIn E{(bf16_t*)(ws + X_GG), (float*)(ws + X_REC)};
    pg8::gemm_phase<EpiLruIn, pg8::Order<MapPlain>, true>(lds, tid, D, D, D, S, E);
}
PHFN void ph_lru_gate(LAS unsigned char* lds, const int tid, unsigned char* ws, const float* gb, int G, int bid) {
    pg8::Order<MapLruGate> S; S.init(R / 256, 32, G, bid, MapLruGate{(const char*)(ws + X_XCB), (const char*)(ws + W_LRU_G)});
    EpiLruGate E{(const float*)(ws + X_XCF), gb, (const float*)(ws + WS_SP), (float*)(ws + X_AB), (float*)(ws + X_BB)};
    pg8::gemm_phase<EpiLruGate, pg8::Order<MapLruGate>, true>(lds, tid, 256, D, 256, S, E);
}
PHFN void ph_qkv(LAS unsigned char* lds, const int tid, unsigned char* ws, int swa, int G, int bid) {
    pg8::Order<MapPlain> S; S.init(R / 256, swa ? 12 : 24, G, bid, MapPlain{(const char*)(ws + WS_U), (const char*)(ws + (swa ? W_SWA_QKV : W_DIF_QKV)), (size_t)256 * D * 2, (size_t)256 * D * 2});
    EpiQKV E{(bf16_t*)(ws + X_Q1), (bf16_t*)(ws + X_K1), (bf16_t*)(ws + (swa ? X_VT3 : X_VT1)), swa ? 512 : 2048, swa ? 6 : 7, swa ? 8 : 16};
    pg8::gemm_phase<EpiQKV, pg8::Order<MapPlain>, true>(lds, tid, D, D, D, S, E);
}
PHFN void ph_ret_qkvg(LAS unsigned char* lds, const int tid, unsigned char* ws, int G, int bid) {
    pg8::Order<MapPlain> S; S.init(R / 256, 48, G, bid, MapPlain{(const char*)(ws + WS_U), (const char*)(ws + W_RET_QKVG), (size_t)256 * D * 2, (size_t)256 * D * 2});
    EpiRetQKVG E{(bf16_t*)(ws + X_Q2), (bf16_t*)(ws + X_K2), (bf16_t*)(ws + X_KTF), (bf16_t*)(ws + X_KTB), (bf16_t*)(ws + X_A3), (bf16_t*)(ws + X_B3), (bf16_t*)(ws + X_SG)};
    pg8::gemm_phase<EpiRetQKVG, pg8::Order<MapPlain>, true>(lds, tid, D, D, D, S, E);
}
PHFN void ph_ret_s(LAS unsigned char* lds, const int tid, unsigned char* ws, int G, int bid) {
    pg8::Order<MapRetS> S; S.init(R / 256, 8, G, bid, MapRetS{(const char*)(ws + X_Q2), (const char*)(ws + X_K2)});
    EpiRetS E{(bf16_t*)(ws + X_A3)};
    pg8::gemm_phase<EpiRetS, pg8::Order<MapRetS>, true>(lds, tid, 256, D, D, S, E);
}
PHFN void ph_ret_kv(LAS unsigned char* lds, const int tid, unsigned char* ws, int G, int bid) {
    pg8::Order<MapRetKV> S; S.init(R / 256, 32, G, bid, MapRetKV{(const char*)(ws + X_B3), (const char*)(ws + X_KTF), (const char*)(ws + X_KTB)});
    EpiRetKV E{(float*)(ws + X_KVT)};
    pg8::gemm_phase<EpiRetKV, pg8::Order<MapRetKV>, true>(lds, tid, 256, 768, 256, S, E);
}
PHFN void ph_ret_out(LAS unsigned char* lds, const int tid, unsigned char* ws, int G, int bid) {
    pg8::Order<MapRetOut> S; S.init(R / 256, 16, G, bid, MapRetOut{(const char*)(ws + X_A3), (const char*)(ws + X_B3)});
    EpiRetOut E{(float*)(ws + X_O2)};
    pg8::gemm_phase<EpiRetOut, pg8::Order<MapRetOut>, true>(lds, tid, 768, 8 * 768, 768, S, E);
}
template <int K> PHFN void ph_resid(LAS unsigned char* lds, const int tid, unsigned char* ws, const bf16_t* A, const bf16_t* W, int nrows, const float* gate, int G, int bid) {
    pg8::Order<MapPlain> S; S.init(nrows / 256, 8, G, bid, MapPlain{(const char*)A, (const char*)W, (size_t)256 * K * 2, (size_t)256 * K * 2});
    EpiResid E{(const float*)(ws + WS_H), (float*)(ws + WS_T), gate};
    pg8::gemm_phase<EpiResid, pg8::Order<MapPlain>, true>(lds, tid, K, K, K, S, E);
}
PHFN void ph_up(LAS unsigned char* lds, const int tid, unsigned char* ws, int layer, int nrows, int G, int bid) {
    pg8::Order<MapPlain> S; S.init(nrows / 256, FF / 256, G, bid, MapPlain{(const char*)(ws + WS_U), (const char*)(ws + W_MLP1) + (size_t)layer * D * FF * 2, (size_t)256 * D * 2, (size_t)256 * D * 2});
    EpiMlpUp E{(bf16_t*)(ws + X_ACT)};
    pg8::gemm_phase<EpiMlpUp, pg8::Order<MapPlain>, true>(lds, tid, D, D, D, S, E);
}
PHFN void ph_attn_dif(LAS unsigned char* lds, const int tid, unsigned char* ws, int G, int bid) {
    const bf16_t* Q1 = (const bf16_t*)(ws + X_Q1); const bf16_t* K1 = (const bf16_t*)(ws + X_K1); const bf16_t* VT1 = (const bf16_t*)(ws + X_VT1); float* OD = (float*)(ws + X_OD);
#pragma unroll 1
    for (int u = bid; u < 1152; u += G) {
        int b, h, mm, qrow, nt0;
        if (u < 1024) { const int qb = u & 7; mm = (u >> 3) & 1; h = (u >> 4) & 15; b = u >> 8; qrow = b * SEQ + qb * 256; nt0 = 32; }
        else { const int v = u - 1024; mm = v & 1; h = (v >> 1) & 15; b = v >> 5; qrow = RL + b * CTX; nt0 = 0; }
        const int hc = h * 128 + mm * 64;
        const bf16_t* vt = VT1 + ((size_t)(b * 16 + h) * 128) * NTOK;
        attn_unit<128, false>(lds, tid, Q1 + (size_t)qrow * D + hc, D, K1 + (size_t)(b * SEQ) * D + hc, K1 + (size_t)(RL + b * CTX) * D + hc, D,
                              vt, vt + SEQ, NTOK, nt0, 4, false, 0, 0, false, 0.f, OD + (size_t)mm * R * D + (size_t)qrow * D + h * 128, D);
    }
}
PHFN void ph_attn_swa(LAS unsigned char* lds, const int tid, unsigned char* ws, const float* sink, int G, int bid) {
    const bf16_t* Q3 = (const bf16_t*)(ws + X_Q3); const bf16_t* K3 = (const bf16_t*)(ws + X_K3); const bf16_t* VT3 = (const bf16_t*)(ws + X_VT3); bf16_t* AO = (bf16_t*)(ws + X_AO);
#pragma unroll 1
    for (int u = bid; u < 1024; u += G) {
        const int qb = u & 7, hq = (u >> 3) & 31, b = u >> 8, kvh = hq >> 2; const int qrow = b * SEQ + qb * 256;
        const int klo = qb * 256 - 128 < 0 ? 0 : qb * 256 - 128, khi = qb * 256 + 384 > SEQ ? SEQ : qb * 256 + 384;
        const bf16_t* vt = VT3 + ((size_t)(b * 8 + kvh) * 64) * NTOK;
        attn_unit<64, true>(lds, tid, Q3 + (size_t)qrow * D + hq * 64, D, K3 + (size_t)(b * SEQ + klo) * 512 + kvh * 64, K3 + (size_t)(RL + b * CTX) * 512 + kvh * 64, 512,
                            vt + klo, vt + SEQ, NTOK, (khi - klo) / 64, 4, true, qb * 256, klo, true, sink[hq] * LOG2E, AO + (size_t)qrow * D + hq * 64, D);
    }
}

__global__ void __launch_bounds__(NTHR, 2) fwd(Args args) {
    extern __shared__ __attribute__((aligned(16))) unsigned char lds_raw[];
    LAS unsigned char* lds = (LAS unsigned char*)lds_raw;
    for (int u = threadIdx.x; u < (LDS_BYTES - RING_BYTES) / 4; u += NTHR) ((LAS unsigned*)(lds + RING_BYTES))[u] = 0u;
    __syncthreads();
    (void)xcd_barrier_post((unsigned*)(args.ws + WS_CTL) + CW_BAR, (volatile LAS unsigned*)(lds + MISC_OFF) + 8);
#ifdef PH_TEST
    const int lo = PH_TEST, hi = PH_TEST + 1;
#else
    const int lo = args.ph_lo, hi = args.ph_hi;
#endif
#define IN(k) (lo <= (k) && (k) < hi)
#define PH_BEGIN() int tid = threadIdx.x, bid = blockIdx.x, G = gridDim.x; unsigned char* ws = launder_ptr(args.ws); \
    asm volatile("" : "+v"(tid), "+v"(bid), "+v"(G)); bid = __builtin_amdgcn_readfirstlane(bid); G = __builtin_amdgcn_readfirstlane(G); \
    const int lane = tid & 63, wave = __builtin_amdgcn_readfirstlane(tid >> 6); \
    const int gw = bid * NWAVES + wave, NGW = G * NWAVES; const size_t gtid = (size_t)bid * NTHR + tid, NGT = (size_t)G * NTHR; \
    (void)lane; (void)wave; (void)gw; (void)NGW; (void)gtid; (void)NGT; \
    float* MOD = (float*)(ws + WS_MOD); float* SP = (float*)(ws + WS_SP); float* PART = (float*)(ws + WS_PART); \
    float* Hs = (float*)(ws + WS_H); float* Ts = (float*)(ws + WS_T); bf16_t* Us = (bf16_t*)(ws + WS_U); \
    (void)MOD; (void)SP; (void)PART; (void)Hs; (void)Ts; (void)Us;
#define INP(k) input_ptr(args, (k))
#define SEAM(k) do { if ((k) + 1 < hi) { unsigned char* wsb = launder_ptr(args.ws); XcdBarrier bar; bar.bar = (unsigned*)(wsb + WS_CTL) + CW_BAR; bar.x = xb_xcc_id(); \
    bar.st = (volatile LAS unsigned*)(lds + MISC_OFF) + 8; xcd_barrier(bar); } } while (0)

    if (IN(0)) { PH_BEGIN();
        LAS float* sl = (LAS float*)(lds + 81920);
        for (int i = tid; i < 5 * D; i += NTHR) { const int r = i >> 11, k = i & (D - 1); const float v = r < 4 ? INP(I_C)[r * D + k] : INP(I_CCTX)[k]; sl[i] = siluf(v); }
        __syncthreads();
        for (int task = gw; task < 4 * 8 * 48; task += NGW) {
            const int cc = task % 48, ks = (task / 48) & 7, l = task / 384; const int n0 = cc * 256 + lane * 4;
            const float* wp = INP(I_ADAW) + ((size_t)l * D + ks * 256) * MODW + n0;
            f32x4 a0 = {0, 0, 0, 0}, a1 = a0, a2 = a0, a3 = a0, a4 = a0;
#pragma unroll 8
            for (int k = 0; k < 256; ++k) { const f32x4 wv = *(const f32x4*)(wp + (size_t)k * MODW); const int kk = ks * 256 + k;
                a0 += wv * sl[kk]; a1 += wv * sl[D + kk]; a2 += wv * sl[2 * D + kk]; a3 += wv * sl[3 * D + kk]; a4 += wv * sl[4 * D + kk]; }
            float* pp = PART + ((size_t)(ks * 4 + l) * 5) * MODW + n0;
            *(f32x4*)(pp) = a0; *(f32x4*)(pp + MODW) = a1; *(f32x4*)(pp + 2 * MODW) = a2; *(f32x4*)(pp + 3 * MODW) = a3; *(f32x4*)(pp + 4 * MODW) = a4;
        }
        LAS float* scr = (LAS float*)(lds + wave * 8448);
        int base = 0;
        tr_job(INP(I_LIN), D, 4096, (bf16_t*)(ws + W_LRU_IN), scr, lane, gw, NGW, base);
        {
            const int nitems = 64 * 16;
            for (int it = ((gw - base) % NGW + NGW) % NGW; it < nitems; it += NGW) { const int sb = it >> 4, kb = (it >> 2) & 3, nb = it & 3;
                const int half = sb & 1, blk = (sb >> 1) & 7, g = (sb >> 4) & 1, dir = sb >> 5;
                const float* src = INP(I_LGW) + (size_t)(((dir * 2 + g) * 8 + blk)) * 65536 + half * 128;
                bf16_t* dst = (bf16_t*)(ws + W_LRU_G) + ((size_t)(((dir * 8 + blk) * 2 + half) * 256 + g * 128)) * 256;
                tr_item(src, 256, dst, 256, 64 * kb, 32 * nb, scr, lane); }
            base += nitems;
        }
        tr_job(INP(I_LOUT), D, D, (bf16_t*)(ws + W_LRU_OUT), scr, lane, gw, NGW, base);
        tr_job(INP(I_DQKV), D, 6144, (bf16_t*)(ws + W_DIF_QKV), scr, lane, gw, NGW, base);
        tr_job(INP(I_DOUT), D, D, (bf16_t*)(ws + W_DIF_OUT), scr, lane, gw, NGW, base);
        tr_job(INP(I_RQKVG), D, 12288, (bf16_t*)(ws + W_RET_QKVG), scr, lane, gw, NGW, base);
        tr_job(INP(I_ROUT), 4096, D, (bf16_t*)(ws + W_RET_OUT), scr, lane, gw, NGW, base);
        tr_job(INP(I_SQKV), D, 3072, (bf16_t*)(ws + W_SWA_QKV), scr, lane, gw, NGW, base);
        tr_job(INP(I_SOUT), D, D, (bf16_t*)(ws + W_SWA_OUT), scr, lane, gw, NGW, base);
#pragma unroll 1
        for (int l = 0; l < DEPTH; ++l) {
            tr_job(INP(I_W1) + (size_t)l * D * FF, D, FF, (bf16_t*)(ws + W_MLP1) + (size_t)l * D * FF, scr, lane, gw, NGW, base);
            tr_job(INP(I_W2) + (size_t)l * D * FF, FF, D, (bf16_t*)(ws + W_MLP2) + (size_t)l * D * FF, scr, lane, gw, NGW, base);
        }
        __syncthreads();
        SEAM(0);
    }
    if (IN(1)) { PH_BEGIN();
        for (size_t i = gtid; i < (size_t)4 * 5 * MODW; i += NGT) { const int n = (int)(i % MODW); const int l = (int)(i / (5 * MODW));
            float s = INP(I_ADAB)[l * MODW + n];
#pragma unroll
            for (int ks = 0; ks < 8; ++ks) s += PART[(size_t)ks * 4 * 5 * MODW + i];
            MOD[i] = s; }
        for (size_t i = gtid; i < 2 * D; i += NGT) { const float lam = INP(I_LLAM)[i]; const float x = ex2(-lam * LOG2E);
            const float sp = x < 0.05f ? x * (1.f + x * (-0.5f + x * (1.f / 3.f + x * (-0.25f + x * (0.2f - x * (1.f / 6.f)))))) : logf(1.f + x);
            SP[i] = -8.f * sp; }
        SEAM(1);
    }
    if (IN(2)) { PH_BEGIN();
        for (size_t i = gtid; i < (size_t)R * (D / 4); i += NGT) { const int row = (int)(i >> 9), c4 = (int)(i & 511) * 4;
            const f32x4 v = row < RL ? *(const f32x4*)(INP(I_X) + (size_t)row * D + c4) : *(const f32x4*)(INP(I_CTX) + (size_t)(row - RL) * D + c4);
            const float* mp = MOD + (size_t)mod_row(row) * MODW; const f32x4 sh = *(const f32x4*)(mp + c4), sc = *(const f32x4*)(mp + D + c4);
            *(f32x4*)(Hs + (size_t)row * D + c4) = v; *(u32x2*)(Us + (size_t)row * D + c4) = pk4(v * (sc + 1.f) + sh); }
        SEAM(2);
    }

#pragma unroll 1
    for (int layer = 0; layer < DEPTH; ++layer) {
        const int Lb = 3 + 12 * layer;
        const int nrows = layer == DEPTH - 1 ? RL : R;
#define LAYER_VARS() const float* modl = MOD + (size_t)layer * 5 * MODW; (void)modl; \
        const bf16_t* YIN = (const bf16_t*)(ws + (layer == 0 ? X_YIN : layer == 1 ? X_DO : layer == 2 ? X_RO : X_AO)); (void)YIN; \
        const bf16_t* WOUT = (const bf16_t*)(ws + (layer == 0 ? W_LRU_OUT : layer == 1 ? W_DIF_OUT : layer == 2 ? W_RET_OUT : W_SWA_OUT)); (void)WOUT;

        if (layer == 0) {
#define LRU_VARS() bf16_t* GG = (bf16_t*)(ws + X_GG); float* REC = (float*)(ws + X_REC); bf16_t* XCB = (bf16_t*)(ws + X_XCB); float* XCF = (float*)(ws + X_XCF); \
            float* AB = (float*)(ws + X_AB); float* BB = (float*)(ws + X_BB); float* CAR = (float*)(ws + X_CARRY); bf16_t* YO = (bf16_t*)(ws + X_YIN); \
            (void)GG; (void)REC; (void)XCB; (void)XCF; (void)AB; (void)BB; (void)CAR; (void)YO;
            if (IN(Lb + 0)) { PH_BEGIN(); ph_lru_in(lds, tid, ws, G, bid); SEAM(Lb + 0); }
            if (IN(Lb + 1)) { PH_BEGIN(); LRU_VARS();
                const float* cw = INP(I_LCW); const float* cb = INP(I_LCB);
                for (size_t i = gtid; i < (size_t)R * (D / 4); i += NGT) { const int row = (int)(i >> 9), c4 = (int)(i & 511) * 4;
                    const int t = row < RL ? (row & (SEQ - 1)) : ((row - RL) & (CTX - 1)), len = row < RL ? SEQ : CTX;
                    f32x4 a = *(const f32x4*)(cb + c4);
#pragma unroll
                    for (int k = 0; k < 4; ++k) { const int tt = t + k - 2; if (tt >= 0 && tt < len) a += *(const f32x4*)(cw + k * D + c4) * *(const f32x4*)(REC + (size_t)(row + k - 2) * D + c4); }
                    *(f32x4*)(XCF + (size_t)row * D + c4) = a; *(u32x2*)(XCB + (size_t)row * D + c4) = pk4(a); }
                SEAM(Lb + 1);
            }
            if (IN(Lb + 2)) { PH_BEGIN(); ph_lru_gate(lds, tid, ws, INP(I_LGB), G, bid); SEAM(Lb + 2); }
            if (IN(Lb + 3)) { PH_BEGIN(); LRU_VARS();
                for (int task = gw; task < 2 * 4 * 36 * 32; task += NGW) {
                    const int g = task & 31, c = (task >> 5) % 36, b = ((task >> 5) / 36) & 3, dir = (task >> 5) / 144; const int ch = g * 64 + lane;
                    int row0, stp;
                    if (dir == 0) { row0 = c < 4 ? RL + b * CTX + 64 * c : b * SEQ + 64 * (c - 4); stp = 1; }
                    else { row0 = c < 4 ? RL + b * CTX + 255 - 64 * c : b * SEQ + 2047 - 64 * (c - 4); stp = -1; }
                    const float* ap = AB + ((size_t)dir * R + row0) * D + ch; const float* bp = BB + ((size_t)dir * R + row0) * D + ch; const long st = (long)stp * D;
                    float pa = 1.f, h = 0.f;
#pragma unroll 8
                    for (int s = 0; s < 64; ++s) { const float a = ap[s * st], bb = bp[s * st]; pa *= a; h = a * h + bb; }
                    float* cp = CAR + (((size_t)(dir * 4 + b) * 36 + c) * 2) * D + ch; cp[0] = pa; cp[D] = h;
                }
                SEAM(Lb + 3);
            }
            if (IN(Lb + 4)) { PH_BEGIN(); LRU_VARS();
                LAS float* hf = (LAS float*)(lds + wave * 16384);
                for (int task = gw; task < 4 * 36 * 32; task += NGW) {
                    const int g = task & 31, n = (task >> 5) % 36, b = (task >> 5) / 36; const int ch = g * 64 + lane;
                    const int rowa = n < 4 ? RL + b * CTX + 64 * n : b * SEQ + 64 * (n - 4);
                    const int cf = n, cbk = n < 4 ? 3 - n : 4 + (31 - (n - 4));
                    float h = 0.f;
                    { const float* cp = CAR + ((size_t)(0 * 4 + b) * 36 * 2) * D + ch; for (int c = 0; c < cf; ++c) h = cp[(size_t)(c * 2) * D] * h + cp[(size_t)(c * 2 + 1) * D]; }
                    { const float* ap = AB + ((size_t)rowa) * D + ch; const float* bp = BB + ((size_t)rowa) * D + ch;
#pragma unroll 8
                      for (int s = 0; s < 64; ++s) { h = ap[(size_t)s * D] * h + bp[(size_t)s * D]; hf[s * 64 + lane] = h; } }
                    h = 0.f;
                    { const float* cp = CAR + ((size_t)(1 * 4 + b) * 36 * 2) * D + ch; for (int c = 0; c < cbk; ++c) h = cp[(size_t)(c * 2) * D] * h + cp[(size_t)(c * 2 + 1) * D]; }
                    { const float* ap = AB + ((size_t)R + rowa) * D + ch; const float* bp = BB + ((size_t)R + rowa) * D + ch;
#pragma unroll 8
                      for (int s = 63; s >= 0; --s) { h = ap[(size_t)s * D] * h + bp[(size_t)s * D]; const size_t o = (size_t)(rowa + s) * D + ch; YO[o] = f2bf(bf2f(GG[o]) * (hf[s * 64 + lane] + h)); } }
                }
                SEAM(Lb + 4);
            }
        } else if (layer == 1) {
            if (IN(Lb + 0)) { PH_BEGIN(); ph_qkv(lds, tid, ws, 0, G, bid); SEAM(Lb + 0); }
            if (IN(Lb + 1)) { PH_BEGIN(); ph_attn_dif(lds, tid, ws, G, bid); SEAM(Lb + 1); }
            if (IN(Lb + 2)) { PH_BEGIN(); float* OD = (float*)(ws + X_OD); bf16_t* DO = (bf16_t*)(ws + X_DO);
                const float* dl = INP(I_DLAM); const float lam_init = 0.8f - 0.6f * 0.7408182206817179f;
                const float s1 = wave_sum(dl[lane] * dl[64 + lane]), s2 = wave_sum(dl[128 + lane] * dl[192 + lane]);
                const float lamf = expf(s1) - expf(s2) + lam_init;
                const f32x4 sub = *(const f32x4*)(INP(I_DSUB) + ((lane & 31) * 4)) * (1.f - lam_init);
                for (int row = gw; row < R; row += NGW) {
#pragma unroll
                    for (int j = 0; j < 8; ++j) { const size_t o = (size_t)row * D + j * 256 + lane * 4; const f32x4 v = *(const f32x4*)(OD + o) - *(const f32x4*)(OD + (size_t)R * D + o) * lamf;
                        float ss = (v[0] * v[0] + v[1] * v[1]) + (v[2] * v[2] + v[3] * v[3]);
#pragma unroll
                        for (int x = 1; x < 32; x <<= 1) ss += __shfl_xor(ss, x);
                        const float rs = 1.f / sqrtf(ss * (1.f / 128.f) + LN_EPS);
                        *(u32x2*)(DO + o) = pk4(v * rs * sub); }
                }
                SEAM(Lb + 2);
            }
        } else if (layer == 2) {
            if (IN(Lb + 0)) { PH_BEGIN(); ph_ret_qkvg(lds, tid, ws, G, bid); SEAM(Lb + 0); }
            if (IN(Lb + 1)) { PH_BEGIN(); ph_ret_s(lds, tid, ws, G, bid); SEAM(Lb + 1); }
            if (IN(Lb + 2)) { PH_BEGIN(); ph_ret_kv(lds, tid, ws, G, bid); SEAM(Lb + 2); }
            if (IN(Lb + 3)) { PH_BEGIN(); bf16_t* B3 = (bf16_t*)(ws + X_B3); float* KVT = (float*)(ws + X_KVT);
                for (size_t i = gtid; i < (size_t)64 * 32768; i += NGT) { const int e4 = (int)(i & 32767), hd = (int)(i >> 15) & 15, b = (int)(i >> 19);
                    const int h = hd >> 1, dir = hd & 1; const int dv = e4 >> 6, dk = (e4 & 63) * 4;
                    const float cdec = ex2(256.f * ret_log2g(dir ? 7 - h : h));
                    f32x4 acc = {0.f, 0.f, 0.f, 0.f};
#pragma unroll 1
                    for (int s = 0; s < 9; ++s) { const int pm = s == 0 ? 32 + b : (dir == 0 ? b * 8 + (s - 1) : b * 8 + (8 - s));
                        *(u32x2*)(B3 + (((size_t)pm * 8 + h) * 512 + dv) * 768 + dir * 256 + dk) = pk4(acc);
                        acc = acc * cdec + *(const f32x4*)(KVT + (((size_t)pm * 16 + hd) * 512 + dv) * 256 + dk); }
                }
                SEAM(Lb + 3);
            }
            if (IN(Lb + 4)) { PH_BEGIN(); ph_ret_out(lds, tid, ws, G, bid); SEAM(Lb + 4); }
            if (IN(Lb + 5)) { PH_BEGIN(); float* O2 = (float*)(ws + X_O2); bf16_t* RO = (bf16_t*)(ws + X_RO); bf16_t* SG = (bf16_t*)(ws + X_SG);
                for (int row = gw; row < R; row += NGW) {
#pragma unroll
                    for (int hh = 0; hh < 8; ++hh) { const size_t o = (size_t)row * 4096 + hh * 512 + lane * 4; const f32x4 v0 = *(const f32x4*)(O2 + o), v1 = *(const f32x4*)(O2 + o + 256);
                        const float ss = wave_sum((v0[0] * v0[0] + v0[1] * v0[1]) + (v0[2] * v0[2] + v0[3] * v0[3]) + (v1[0] * v1[0] + v1[1] * v1[1]) + (v1[2] * v1[2] + v1[3] * v1[3]));
                        const float rs = 1.f / sqrtf(ss * (1.f / 512.f) + LN_EPS);
                        const u32x2 g0 = *(const u32x2*)(SG + o), g1 = *(const u32x2*)(SG + o + 256);
                        f32x4 ga, gb2; ga[0] = __uint_as_float(g0.x << 16); ga[1] = __uint_as_float(g0.x & 0xffff0000u); ga[2] = __uint_as_float(g0.y << 16); ga[3] = __uint_as_float(g0.y & 0xffff0000u);
                        gb2[0] = __uint_as_float(g1.x << 16); gb2[1] = __uint_as_float(g1.x & 0xffff0000u); gb2[2] = __uint_as_float(g1.y << 16); gb2[3] = __uint_as_float(g1.y & 0xffff0000u);
                        *(u32x2*)(RO + o) = pk4(v0 * rs * ga); *(u32x2*)(RO + o + 256) = pk4(v1 * rs * gb2); }
                }
                SEAM(Lb + 5);
            }
        } else {
            if (IN(Lb + 0)) { PH_BEGIN(); ph_qkv(lds, tid, ws, 1, G, bid); SEAM(Lb + 0); }
            if (IN(Lb + 1)) { PH_BEGIN(); ph_attn_swa(lds, tid, ws, INP(I_SSINK), G, bid); SEAM(Lb + 1); }
        }

        if (IN(Lb + 7)) { PH_BEGIN(); LAYER_VARS(); if (layer == 2) ph_resid<4096>(lds, tid, ws, YIN, WOUT, nrows, modl + 2 * D, G, bid); else ph_resid<D>(lds, tid, ws, YIN, WOUT, nrows, modl + 2 * D, G, bid); SEAM(Lb + 7); }
#pragma unroll 1
        for (int which = 0; which < 2; ++which) {
            if (which == 1) {
                if (IN(Lb + 9)) { PH_BEGIN(); ph_up(lds, tid, ws, layer, nrows, G, bid); SEAM(Lb + 9); }
                if (IN(Lb + 10)) { PH_BEGIN(); LAYER_VARS(); ph_resid<FF>(lds, tid, ws, (const bf16_t*)(ws + X_ACT), (const bf16_t*)(ws + W_MLP2) + (size_t)layer * D * FF, nrows, modl + 5 * D, G, bid); SEAM(Lb + 10); }
            }
            const int pid = Lb + (which == 0 ? 8 : 11);
            if (IN(pid)) { PH_BEGIN(); LAYER_VARS();
                const float* lg = INP(I_LNG) + (size_t)(layer * 2 + which) * D; const float* lb = INP(I_LNB) + (size_t)(layer * 2 + which) * D;
                const bool fin = (layer == DEPTH - 1 && which == 1);
                const float* mbase = which == 0 ? modl + 3 * D : modl + 5 * MODW;
                for (int row = gw; row < nrows; row += NGW) {
                    const float* tp = Ts + (size_t)row * D + lane * 4;
                    f32x4 v[8]; float s = 0.f;
#pragma unroll
                    for (int j = 0; j < 8; ++j) { v[j] = *(const f32x4*)(tp + 256 * j); s += (v[j][0] + v[j][1]) + (v[j][2] + v[j][3]); }
                    const float mean = wave_sum(s) * (1.f / D); float s2 = 0.f;
#pragma unroll
                    for (int j = 0; j < 8; ++j) { v[j] = v[j] - mean; s2 += (v[j][0] * v[j][0] + v[j][1] * v[j][1]) + (v[j][2] * v[j][2] + v[j][3] * v[j][3]); }
                    const float rstd = 1.f / sqrtf(wave_sum(s2) * (1.f / D) + LN_EPS);
                    const float* mp = mbase + (size_t)mod_row(row) * MODW;
                    float* hp = (fin ? args.out : Hs) + (size_t)row * D + lane * 4;
#pragma unroll
                    for (int j = 0; j < 8; ++j) { const int c = lane * 4 + 256 * j; const f32x4 y = v[j] * rstd * *(const f32x4*)(lg + c) + *(const f32x4*)(lb + c);
                        *(f32x4*)(hp + 256 * j) = y;
                        if (!fin) { const f32x4 sh = *(const f32x4*)(mp + c), sc = *(const f32x4*)(mp + D + c); *(u32x2*)(Us + (size_t)row * D + c) = pk4(y * (sc + 1.f) + sh); } }
                }
                SEAM(pid);
            }
        }
    }
#undef IN
#undef SEAM
}

__global__ void marker_kernel(float* out, int n, float v) { const int i = blockIdx.x * blockDim.x + threadIdx.x; if (i < n) out[i] = v; }

static bool phase_used(int ph) {
    if (ph < 3) return true;
    const int layer = (ph - 3) / 12, k = (ph - 3) % 12;
    if (k >= 7) return true;
    const int nmix[4] = {5, 3, 6, 2};
    return k < nmix[layer];
}

extern "C" void kernel_launch(void* const* d_in, const int* in_sizes, int n_in, void* d_out, int out_size, void* d_ws, size_t ws_size, hipStream_t stream) {
    static int grid = 0;
    if (grid == 0) {
        int dev = 0, cus = 0;
        if (hipGetDevice(&dev) != hipSuccess || hipDeviceGetAttribute(&cus, hipDeviceAttributeMultiprocessorCount, dev) != hipSuccess) { grid = -1; }
        else if (hipFuncSetAttribute((const void*)fwd, hipFuncAttributeMaxDynamicSharedMemorySize, LDS_BYTES) != hipSuccess) { fprintf(stderr, "kernel_launch: hipFuncSetAttribute failed\n"); grid = -1; }
        else { int per_cu = 0; (void)hipOccupancyMaxActiveBlocksPerMultiprocessor(&per_cu, (const void*)fwd, NTHR, LDS_BYTES); (void)hipGetLastError(); grid = cus; }
    }
    if (grid < 0 || n_in != 26 || out_size != RL * D || ws_size < WS_END) {
        fprintf(stderr, "kernel_launch: bad configuration (grid %d n_in %d out %d ws %zu need %zu)\n", grid, n_in, out_size, ws_size, (size_t)WS_END);
        hipLaunchKernelGGL(marker_kernel, dim3((out_size + 255) / 256), dim3(256), 0, stream, (float*)d_out, out_size, ws_size < WS_END ? 1000.f : 3000.f);
        return;
    }
    (void)hipMemsetAsync((char*)d_ws + WS_CTL, 0, CTL_BYTES, stream);
    Args a{};
    for (int i = 0; i < 26; ++i) a.in[i] = (const float*)d_in[i];
    a.out = (float*)d_out; a.ws = (unsigned char*)d_ws;
#if MK_MULTI
    for (int ph = 0; ph < NPHASE; ++ph) { if (!phase_used(ph)) continue; a.ph_lo = ph; a.ph_hi = ph + 1; hipLaunchKernelGGL(fwd, dim3(grid), dim3(NTHR), LDS_BYTES, stream, a); }
#else
    a.ph_lo = 0; a.ph_hi = NPHASE;
    hipLaunchKernelGGL(fwd, dim3(grid), dim3(NTHR), LDS_BYTES, stream, a);
#endif
}
```

```cpp
#include <hip/hip_runtime.h>
#include <cstdio>
#include <cstdint>

#ifndef MK_MULTI
#define MK_MULTI 0
#endif

#define LAS __attribute__((address_space(3)))
#define GAS __attribute__((address_space(1)))
typedef unsigned short bf16_t;
typedef short bf16x8 __attribute__((ext_vector_type(8)));
typedef float f32x4 __attribute__((ext_vector_type(4)));
typedef float f32x2 __attribute__((ext_vector_type(2)));
typedef float f32x16 __attribute__((ext_vector_type(16)));
typedef unsigned u32x4 __attribute__((ext_vector_type(4)));
typedef unsigned u32x2 __attribute__((ext_vector_type(2)));

constexpr int D = 2048, NB = 4, SEQ = 2048, CTX = 256, DEPTH = 4, FF = 8192;
constexpr int RL = NB * SEQ, RC = NB * CTX, R = RL + RC;
constexpr int NTOK = SEQ + CTX;
constexpr float LN_EPS = 1e-5f;
constexpr float ALPHA = 1.681792830507429f;
constexpr float LOG2E = 1.4426950408889634f;
constexpr int MODW = 6 * D;

constexpr size_t MiB = (size_t)1 << 20;
constexpr size_t WS_CTL = 0, CTL_BYTES = 1 * MiB;
constexpr size_t WS_MOD = 1 * MiB;
constexpr size_t WS_SP = 2 * MiB;
constexpr size_t WS_PART = 3 * MiB;
constexpr size_t WS_W = 11 * MiB;
constexpr size_t W_LRU_IN = WS_W, W_LRU_G = WS_W + 16 * MiB, W_LRU_OUT = WS_W + 20 * MiB, W_DIF_QKV = WS_W + 28 * MiB, W_DIF_OUT = WS_W + 52 * MiB,
                 W_RET_QKVG = WS_W + 60 * MiB, W_RET_OUT = WS_W + 108 * MiB, W_SWA_QKV = WS_W + 124 * MiB, W_SWA_OUT = WS_W + 136 * MiB,
                 W_MLP1 = WS_W + 144 * MiB, W_MLP2 = WS_W + 272 * MiB;
constexpr size_t WS_H = 411 * MiB, WS_T = 483 * MiB, WS_U = 555 * MiB, WS_X = 591 * MiB;
constexpr size_t X_ACT = WS_X;
constexpr size_t X_GG = WS_X, X_REC = WS_X + 36 * MiB, X_XCB = WS_X + 108 * MiB, X_XCF = WS_X + 144 * MiB, X_AB = WS_X + 216 * MiB, X_BB = WS_X + 360 * MiB,
                 X_CARRY = WS_X + 504 * MiB, X_YIN = WS_X + 512 * MiB;
constexpr size_t X_Q1 = WS_X, X_K1 = WS_X + 36 * MiB, X_VT1 = WS_X + 72 * MiB, X_OD = WS_X + 108 * MiB, X_DO = WS_X + 252 * MiB;
constexpr size_t X_Q2 = WS_X, X_K2 = WS_X + 36 * MiB, X_KTF = WS_X + 72 * MiB, X_KTB = WS_X + 108 * MiB, X_A3 = WS_X + 144 * MiB, X_B3 = WS_X + 252 * MiB,
                 X_KVT = WS_X + 468 * MiB, X_O2 = X_KVT, X_RO = WS_X, X_SG = WS_T;
constexpr size_t X_Q3 = WS_X, X_K3 = WS_X + 36 * MiB, X_VT3 = WS_X + 48 * MiB, X_AO = WS_X + 60 * MiB;
constexpr size_t X_PARTK = WS_X + 160 * MiB;
constexpr size_t WS_END = WS_X + 756 * MiB;

__device__ __forceinline__ unsigned cvt_pk_bf16(float lo, float hi) { unsigned r; asm volatile("v_cvt_pk_bf16_f32 %0, %1, %2" : "=v"(r) : "v"(lo), "v"(hi)); return r; }
__device__ __forceinline__ bf16_t f2bf(float x) { return (bf16_t)(cvt_pk_bf16(x, 0.f) & 0xffffu); }
__device__ __forceinline__ u32x2 pk4(f32x4 v) { u32x2 w; w.x = cvt_pk_bf16(v[0], v[1]); w.y = cvt_pk_bf16(v[2], v[3]); return w; }
__device__ __forceinline__ float bf2f(bf16_t u) { return __uint_as_float(((unsigned)u) << 16); }
__device__ __forceinline__ float ex2(float x) { return __builtin_amdgcn_exp2f(x); }
__device__ __forceinline__ float rcpf(float x) { return __builtin_amdgcn_rcpf(x); }
__device__ __forceinline__ float sigmoidf(float x) { return rcpf(1.f + ex2(-x * LOG2E)); }
__device__ __forceinline__ float siluf(float x) { return x * sigmoidf(x); }
__device__ __forceinline__ float gelu_tanh(float x) { const float z = 0.7978845608028654f * (x + 0.044715f * x * x * x); return x * rcpf(1.f + ex2(-2.f * LOG2E * z)); }
__device__ __forceinline__ int mod_row(int row) { return row < RL ? (row >> 11) : 4; }
__device__ __forceinline__ float wave_sum(float v) {
#pragma unroll
    for (int o = 1; o < 64; o <<= 1) v += __shfl_xor(v, o);
    return v;
}
__device__ __forceinline__ float ret_log2g(int h) {
    const float x = ex2(-5.f - (float)h);
    const float s = x * (1.f + x * (0.5f + x * (1.f / 3.f + x * (0.25f + x * (0.2f + x * (1.f / 6.f + x * (1.f / 7.f)))))));
    return -s * LOG2E;
}

namespace pg8 {
constexpr int BM = 256, BK = 64, HALF = 128, HTB = HALF * BK * 2, STAGE_BYTES = 8 * HTB, NXCD = 8, WGM = 8;
__host__ __device__ __forceinline__ int lds_byte(int r, int c) { const int st = (r >> 4) * 2 + (c >> 5), rr = r & 15, cc = c & 31, ob = rr * 64 + cc * 2; return st * 1024 + (ob ^ (((ob >> 9) & 1) << 5)); }
__host__ __device__ __forceinline__ void stage_rc(int b, int& Rr, int& C) { const int st = b / 1024, sb = b % 1024, swz = sb ^ (((sb >> 9) & 1) << 5); Rr = (st >> 1) * 16 + swz / 64; C = (st & 1) * 32 + (swz % 64) / 2; }

struct Unit { const char* a; const char* b; int pm, pn, nt, aux; };

template <class Map> struct Order {
    int nM, nN, nwg, G, c, nt; Map map;
    __device__ __forceinline__ void init(int nM_, int nN_, int G_, int c_, int K_, const Map& m) { nM = nM_; nN = nN_; nwg = nM_ * nN_; G = G_; c = c_; nt = K_ / BK; map = m; }
    __device__ __forceinline__ bool next(int i, Unit& u) const {
        const long Lx = (long)i * G + c; if (Lx >= nwg) return false;
        int wgid = (int)Lx; { const int q = nwg / NXCD, r = nwg % NXCD, xcd = wgid % NXCD, off = wgid / NXCD; wgid = (xcd < r ? xcd * (q + 1) : r * (q + 1) + (xcd - r) * q) + off; }
        const int nig = WGM * nN, gid = wgid / nig, fm = gid * WGM, gsz = (nM - fm) < WGM ? (nM - fm) : WGM;
        u.pm = fm + ((wgid % nig) % gsz); u.pn = (wgid % nig) / gsz; u.nt = nt; u.aux = 0; map(u); return true;
    }
};

template <class Epi, class Sched, bool ALIGN_EPI>
__device__ __forceinline__ void gemm_phase(LAS unsigned char* lds, const int tid, const int K, const int lda, const int ldb, const Sched& S, const Epi& E) {
    const int wid = __builtin_amdgcn_readfirstlane(tid >> 6), lane = tid & 63, wr = wid >> 2, wc = wid & 3, fr = lane & 15, fq = lane >> 4;
    unsigned voffA[2], voffB[2];
#pragma unroll
    for (int i = 0; i < 2; ++i) { int Rr, C; stage_rc(tid * 16 + i * 8192, Rr, C); voffA[i] = (unsigned)(Rr * lda + C) * 2u; voffB[i] = (unsigned)(Rr * ldb + C) * 2u; }
    const size_t kstep = (size_t)(BK * 2);
    const size_t hstepA = (size_t)HALF * lda * 2, hstepB = (size_t)HALF * ldb * 2;
    const unsigned ldsw = (unsigned)wid * 1024u;
    const int aoff = lds_byte(wr * 64 + fr, fq * 8), boff = lds_byte(wc * 32 + fr, fq * 8);
#define PG8_SA(b, h) (((b) * 2 + (h)) * HTB)
#define PG8_SB(b, h) ((4 + (b) * 2 + (h)) * HTB)
#define PG8_STAGE(bufoff, gbase, voff) do { _Pragma("unroll") for (int _i = 0; _i < 2; ++_i) \
        __builtin_amdgcn_global_load_lds((const unsigned*)((const char*)(gbase) + (voff)[_i]), (LAS unsigned*)(lds + (bufoff) + ldsw + _i * 8192), 16, 0, 0); } while (0)
#define PG8_LDA(dst, b, h) do { _Pragma("unroll") for (int m = 0; m < 4; ++m) _Pragma("unroll") for (int k = 0; k < 2; ++k) dst[m][k] = *(const LAS bf16x8*)(lds + PG8_SA(b, h) + aoff + m * 2048 + k * 1024); } while (0)
#define PG8_LDB(dst, b, h) do { _Pragma("unroll") for (int n = 0; n < 2; ++n) _Pragma("unroll") for (int k = 0; k < 2; ++k) dst[n][k] = *(const LAS bf16x8*)(lds + PG8_SB(b, h) + boff + n * 2048 + k * 1024); } while (0)
#define PG8_MMA(ai, bj, At, Bt) do { __builtin_amdgcn_s_setprio(1); _Pragma("unroll") for (int m = 0; m < 4; ++m) _Pragma("unroll") for (int n = 0; n < 2; ++n) _Pragma("unroll") for (int k = 0; k < 2; ++k) \
        acc[ai][bj][m][n] = __builtin_amdgcn_mfma_f32_16x16x32_bf16(Bt[n][k], At[m][k], acc[ai][bj][m][n], 0, 0, 0); __builtin_amdgcn_s_setprio(0); } while (0)
#define PG8_WAIT_V(n) asm volatile("s_waitcnt vmcnt(" #n ")" ::: "memory")
#define PG8_WAIT_L(n) asm volatile("s_waitcnt lgkmcnt(" #n ")" ::: "memory")
#define PG8_BAR __builtin_amdgcn_s_barrier()
#define PG8_SCHED __builtin_amdgcn_sched_barrier(0)
    Unit cur, nxt; int ui = 0;
    if (!S.next(0, cur)) return;
    f32x4 acc[2][2][4][2];
#pragma unroll
    for (int a = 0; a < 2; ++a)
#pragma unroll
        for (int b = 0; b < 2; ++b)
#pragma unroll
            for (int m = 0; m < 4; ++m)
#pragma unroll
                for (int n = 0; n < 2; ++n) acc[a][b][m][n] = (f32x4){0.f, 0.f, 0.f, 0.f};
    bf16x8 At[4][2], B0[2][2], B1[2][2];
    const char* cA = cur.a; const char* cB = cur.b;
    PG8_STAGE(PG8_SB(0, 0), cB, voffB); PG8_STAGE(PG8_SB(0, 1), cB + hstepB, voffB); PG8_STAGE(PG8_SA(0, 0), cA, voffA); PG8_STAGE(PG8_SA(0, 1), cA + hstepA, voffA);
    if (wr == 1) PG8_BAR;
    PG8_WAIT_V(2); PG8_BAR;
    PG8_STAGE(PG8_SB(1, 0), cB + kstep, voffB); PG8_STAGE(PG8_SA(1, 0), cA + kstep, voffA); PG8_STAGE(PG8_SB(1, 1), cB + hstepB + kstep, voffB);
    PG8_WAIT_V(6); PG8_BAR;
#pragma unroll 1
    for (;;) {
        const bool has_next = S.next(ui + 1, nxt);
        const char* nA = has_next ? nxt.a : cA; const char* nB = has_next ? nxt.b : cB; const int nt = cur.nt;
#pragma unroll 1
        for (int t = 0; t < nt; t += 2) {
            const bool last = (t == nt - 2);
            const char* a1 = cA + (size_t)(t + 1) * kstep;
            const char* a2 = last ? nA : cA + (size_t)(t + 2) * kstep; const char* b2 = last ? nB : cB + (size_t)(t + 2) * kstep;
            const char* a3 = a2 + kstep; const char* b3 = b2 + kstep;
            PG8_LDB(B0, 0, 0); PG8_LDB(B1, 0, 1); PG8_SCHED; PG8_LDA(At, 0, 0); PG8_STAGE(PG8_SA(1, 1), a1 + hstepA, voffA);
            PG8_WAIT_V(8); PG8_WAIT_L(0); PG8_BAR; PG8_MMA(0, 0, At, B0); PG8_MMA(0, 1, At, B1); PG8_BAR; PG8_SCHED;
            PG8_LDA(At, 0, 1); PG8_STAGE(PG8_SB(0, 0), b2, voffB); PG8_STAGE(PG8_SB(0, 1), b2 + hstepB, voffB); PG8_STAGE(PG8_SA(0, 0), a2, voffA);
            PG8_WAIT_V(8); PG8_WAIT_L(0); PG8_BAR; PG8_MMA(1, 0, At, B0); PG8_MMA(1, 1, At, B1); PG8_BAR; PG8_SCHED;
            PG8_LDB(B0, 1, 0); PG8_LDB(B1, 1, 1); PG8_SCHED; PG8_LDA(At, 1, 0); PG8_STAGE(PG8_SA(0, 1), a2 + hstepA, voffA);
            PG8_WAIT_V(8); PG8_WAIT_L(0); PG8_BAR; PG8_MMA(0, 0, At, B0); PG8_MMA(0, 1, At, B1); PG8_BAR; PG8_SCHED;
            PG8_LDA(At, 1, 1); PG8_STAGE(PG8_SB(1, 0), b3, voffB); PG8_STAGE(PG8_SB(1, 1), b3 + hstepB, voffB); PG8_STAGE(PG8_SA(1, 0), a3, voffA);
            PG8_WAIT_V(8); PG8_WAIT_L(0); PG8_BAR; PG8_MMA(1, 0, At, B0); PG8_MMA(1, 1, At, B1); PG8_BAR; PG8_SCHED;
        }
        if constexpr (ALIGN_EPI) { if (wr == 0) PG8_BAR; }
        { int efr = fr, efq = fq, ewr = wr, ewc = wc; asm volatile("" : "+v"(efr), "+v"(efq), "+s"(ewr), "+s"(ewc));
          E(acc, cur, ewr, ewc, efr, efq); }
        if (!has_next) break;
#pragma unroll
        for (int a = 0; a < 2; ++a)
#pragma unroll
            for (int b = 0; b < 2; ++b)
#pragma unroll
                for (int m = 0; m < 4; ++m)
#pragma unroll
                    for (int n = 0; n < 2; ++n) acc[a][b][m][n] = (f32x4){0.f, 0.f, 0.f, 0.f};
        cur = nxt; cA = nA; cB = nB; ++ui;
        if constexpr (ALIGN_EPI) { if (wr == 1) PG8_BAR; }
    }
    PG8_WAIT_V(0);
    if constexpr (!ALIGN_EPI) { if (wr == 0) PG8_BAR; }
    PG8_BAR;
#undef PG8_SA
#undef PG8_SB
#undef PG8_STAGE
#undef PG8_LDA
#undef PG8_LDB
#undef PG8_MMA
#undef PG8_WAIT_V
#undef PG8_WAIT_L
#undef PG8_BAR
#undef PG8_SCHED
}
}
using pg8::Unit;
typedef f32x4 Acc[2][2][4][2];
#define EPI_ROWS(ai, m) _Pragma("unroll") for (int ai = 0; ai < 2; ++ai) _Pragma("unroll") for (int m = 0; m < 4; ++m)
#define EPI_COLS(bj, n) _Pragma("unroll") for (int bj = 0; bj < 2; ++bj) _Pragma("unroll") for (int n = 0; n < 2; ++n)

struct MapPlain { const char* A; const char* B; size_t astep, bstep;
    __device__ __forceinline__ void operator()(Unit& u) const { u.a = A + (size_t)u.pm * astep; u.b = B + (size_t)u.pn * bstep; } };
struct MapLruGate { const char* XC; const char* WG;
    __device__ __forceinline__ void operator()(Unit& u) const { const int blk = (u.pn >> 1) & 7; u.a = XC + ((size_t)u.pm * 256 * D + blk * 256) * 2; u.b = WG + (size_t)u.pn * 256 * 256 * 2; } };
struct MapRetS { const char* Q; const char* Kk;
    __device__ __forceinline__ void operator()(Unit& u) const { const size_t o = ((size_t)u.pm * 256 * D + u.pn * 256) * 2; u.a = Q + o; u.b = Kk + o; } };
struct MapRetKV { const char* B3; const char* KTf; const char* KTb;
    __device__ __forceinline__ void operator()(Unit& u) const { const int half = u.pn & 1, dir = (u.pn >> 1) & 1, h = u.pn >> 2; const size_t ph = (size_t)u.pm * 8 + h;
        u.a = B3 + ((ph * 512 + half * 256) * 768 + 512) * 2; u.b = (dir ? KTb : KTf) + ph * 256 * 256 * 2; } };
struct MapRetOut { const char* A3; const char* B3;
    __device__ __forceinline__ void operator()(Unit& u) const { const int half = u.pn & 1, h = u.pn >> 1; const size_t ph = (size_t)u.pm * 8 + h;
        u.a = A3 + ((size_t)u.pm * 256 * 8 + h) * 768 * 2; u.b = B3 + (ph * 512 + half * 256) * 768 * 2; } };

struct OrderResid {
    const char* A; const char* W; int K, nfullM, nsplitM, G, c;
    __device__ __forceinline__ bool next(int i, Unit& u) const {
        const int L = i * G + c, nfull = nfullM * 8;
        if (L < nfull) { int wgid = L; { const int q = nfull / 8, xcd = wgid % 8, off = wgid / 8; wgid = xcd * q + off; }
            const int nig = 8 * 8, gid = wgid / nig, fm = gid * 8; u.pm = fm + ((wgid % nig) % 8); u.pn = (wgid % nig) / 8; u.nt = K / 64; u.aux = 0;
            u.a = A + (size_t)u.pm * 256 * K * 2; u.b = W + (size_t)u.pn * 256 * K * 2; return true; }
        const int s = L - nfull; if (s >= nsplitM * 64) return false;
        const int xcd = s & 7, j = s >> 3, combo = (xcd * nsplitM * 8) / 8 + (j >> 3), pn = j & 7, cp = combo >> 3, ks = combo & 7;
        u.pm = nfullM + cp; u.pn = pn; u.nt = K / 512; u.aux = 1 + ks;
        u.a = A + ((size_t)u.pm * 256 * K + ks * (K / 8)) * 2; u.b = W + ((size_t)pn * 256 * K + ks * (K / 8)) * 2; return true;
    }
};
struct EpiResid {
    const float* H; float* T; const float* gate; float* PARTK;
    __device__ __forceinline__ void operator()(const Acc& acc, const Unit& u, int wr, int wc, int fr, int fq) const {
        if (u.aux == 0) {
            EPI_ROWS(ai, m) { const int row = u.pm * 256 + ai * 128 + wr * 64 + m * 16 + fr; const float* gp = gate + (size_t)mod_row(row) * MODW;
                EPI_COLS(bj, n) { const int col = u.pn * 256 + bj * 128 + wc * 32 + n * 16 + fq * 4; const size_t o = (size_t)row * D + col;
                    const f32x4 h = *(const f32x4*)(H + o), g = *(const f32x4*)(gp + col); *(f32x4*)(T + o) = h * ALPHA + g * acc[ai][bj][m][n]; }
                asm volatile("" ::: "memory"); }
        } else {
            float* pb = PARTK + (size_t)(u.aux - 1) * RC * D;
            EPI_ROWS(ai, m) { const int row = u.pm * 256 + ai * 128 + wr * 64 + m * 16 + fr - RL;
                EPI_COLS(bj, n) { const int col = u.pn * 256 + bj * 128 + wc * 32 + n * 16 + fq * 4; *(f32x4*)(pb + (size_t)row * D + col) = acc[ai][bj][m][n]; } }
        }
    }
};
struct EpiMlpUp {
    bf16_t* O;
    __device__ __forceinline__ void operator()(const Acc& acc, const Unit& u, int wr, int wc, int fr, int fq) const {
        EPI_ROWS(ai, m) { const int row = u.pm * 256 + ai * 128 + wr * 64 + m * 16 + fr;
            EPI_COLS(bj, n) { const int col = u.pn * 256 + bj * 128 + wc * 32 + n * 16 + fq * 4; f32x4 v = acc[ai][bj][m][n];
#pragma unroll
                for (int j = 0; j < 4; ++j) { const float r = fmaxf(v[j], 0.f); v[j] = r * r; }
                *(u32x2*)(O + (size_t)row * FF + col) = pk4(v); } }
    }
};
struct EpiLruIn {
    bf16_t* GG; float* REC;
    __device__ __forceinline__ void operator()(const Acc& acc, const Unit& u, int wr, int wc, int fr, int fq) const {
        const bool isg = u.pn < 8;
        EPI_ROWS(ai, m) { const int row = u.pm * 256 + ai * 128 + wr * 64 + m * 16 + fr;
            EPI_COLS(bj, n) { const int col = (u.pn & 7) * 256 + bj * 128 + wc * 32 + n * 16 + fq * 4; f32x4 v = acc[ai][bj][m][n];
                if (isg) {
#pragma unroll
                    for (int j = 0; j < 4; ++j) v[j] = gelu_tanh(v[j]);
                    *(u32x2*)(GG + (size_t)row * D + col) = pk4(v);
                } else *(f32x4*)(REC + (size_t)row * D + col) = v; } }
    }
};
struct EpiLruGate {
    const float* XCF; const float* gb; const float* SP; float* AB; float* BB;
    __device__ __forceinline__ void operator()(const Acc& acc, const Unit& u, int wr, int wc, int fr, int fq) const {
        const int half = u.pn & 1, blk = (u.pn >> 1) & 7, dir = u.pn >> 4;
        EPI_ROWS(ai, m) { const int row = u.pm * 256 + ai * 128 + wr * 64 + m * 16 + fr;
#pragma unroll
            for (int n = 0; n < 2; ++n) { const int ch = blk * 256 + half * 128 + wc * 32 + n * 16 + fq * 4;
                const f32x4 br = *(const f32x4*)(gb + (dir * 2 + 0) * D + ch), bi = *(const f32x4*)(gb + (dir * 2 + 1) * D + ch), sp = *(const f32x4*)(SP + dir * D + ch);
                const f32x4 xc = *(const f32x4*)(XCF + (size_t)row * D + ch); const f32x4 rp = acc[ai][0][m][n] + br, ip = acc[ai][1][m][n] + bi; f32x4 av, bv;
#pragma unroll
                for (int j = 0; j < 4; ++j) { const float r = sigmoidf(rp[j]), ig = sigmoidf(ip[j]); const float la = sp[j] * r; const float a = ex2(la * LOG2E); const float y = 2.f * la;
                    const float om = (y > -0.1f) ? -(y * (1.f + y * (0.5f + y * (1.f / 6.f + y * (1.f / 24.f + y * (1.f / 120.f)))))) : (1.f - ex2(y * LOG2E));
                    av[j] = a; bv[j] = sqrtf(fmaxf(om, 0.f)) * ig * xc[j]; }
                const size_t o = ((size_t)dir * R + row) * D + ch; *(f32x4*)(AB + o) = av; *(f32x4*)(BB + o) = bv; }
            asm volatile("" ::: "memory"); }
    }
};
struct EpiQKV {
    bf16_t* Q; bf16_t* K; bf16_t* VT; int kcols, vshift, vheads;
    __device__ __forceinline__ void operator()(const Acc& acc, const Unit& u, int wr, int wc, int fr, int fq) const {
        const int col0 = u.pn * 256; const int type = col0 < D ? 0 : (col0 < D + kcols ? 1 : 2);
        if (type < 2) {
            float revf[4];
#pragma unroll
            for (int j = 0; j < 4; ++j) revf[j] = ex2(-(float)(fq * 4 + j) * (13.287712379549449f / 16.f)) * 0.15915494309189535f;
            const float qs = type == 0 ? 0.125f * LOG2E : 1.f;
            EPI_ROWS(ai, m) { const int row = u.pm * 256 + ai * 128 + wr * 64 + m * 16 + fr; const bool lat = row < RL; const int t = row & (SEQ - 1);
                const float pos = (wc & 1) ? (float)(t & 63) : (float)(t >> 6);
                float cs[4], sn[4];
#pragma unroll
                for (int j = 0; j < 4; ++j) { const float rv = pos * revf[j]; cs[j] = lat ? __builtin_amdgcn_cosf(rv) : 1.f; sn[j] = lat ? __builtin_amdgcn_sinf(rv) : 0.f; }
#pragma unroll
                for (int bj = 0; bj < 2; ++bj) { const f32x4 x0 = acc[ai][bj][m][0], x1 = acc[ai][bj][m][1]; f32x4 y0, y1;
#pragma unroll
                    for (int j = 0; j < 4; ++j) { y0[j] = (x0[j] * cs[j] - x1[j] * sn[j]) * qs; y1[j] = (x1[j] * cs[j] + x0[j] * sn[j]) * qs; }
                    const int col = col0 + bj * 128 + wc * 32 + fq * 4;
                    if (type == 0) { bf16_t* p = Q + (size_t)row * D + col; *(u32x2*)p = pk4(y0); *(u32x2*)(p + 16) = pk4(y1); }
                    else { bf16_t* p = K + (size_t)row * kcols + (col - D); *(u32x2*)p = pk4(y0); *(u32x2*)(p + 16) = pk4(y1); } } }
        } else {
            EPI_ROWS(ai, m) { const int row = u.pm * 256 + ai * 128 + wr * 64 + m * 16 + fr; const bool lat = row < RL;
                const int b = lat ? (row >> 11) : ((row - RL) >> 8), tk = lat ? (row & (SEQ - 1)) : (SEQ + ((row - RL) & (CTX - 1)));
                EPI_COLS(bj, n) { const int vc = col0 - D - kcols + bj * 128 + wc * 32 + n * 16 + fq * 4; const int hh = vc >> vshift, e = vc & ((1 << vshift) - 1);
                    bf16_t* p = VT + ((size_t)(b * vheads + hh) * (1 << vshift) + e) * NTOK + tk; const f32x4 v = acc[ai][bj][m][n];
#pragma unroll
                    for (int j = 0; j < 4; ++j) p[(size_t)j * NTOK] = f2bf(v[j]); } }
        }
    }
};
struct EpiRetQKVG {
    bf16_t* Q2; bf16_t* K2; bf16_t* KTf; bf16_t* KTb; bf16_t* A3; bf16_t* B3; bf16_t* SG;
    __device__ __forceinline__ void operator()(const Acc& acc, const Unit& u, int wr, int wc, int fr, int fq) const {
        const int pn = u.pn;
        if (pn < 8) { const int h = pn; const float lgf = ret_log2g(h), lgb = ret_log2g(7 - h);
            EPI_ROWS(ai, m) { const int pos = ai * 128 + wr * 64 + m * 16 + fr; const int row = u.pm * 256 + pos; const float df = ex2((float)(pos + 1) * lgf), db = ex2((float)(256 - pos) * lgb);
                EPI_COLS(bj, n) { const int d = bj * 128 + wc * 32 + n * 16 + fq * 4; const f32x4 q = acc[ai][bj][m][n] * 0.0625f;
                    *(u32x2*)(Q2 + (size_t)row * D + h * 256 + d) = pk4(q); bf16_t* ap = A3 + ((size_t)row * 8 + h) * 768 + d;
                    *(u32x2*)ap = pk4(q * df); *(u32x2*)(ap + 256) = pk4(q * db); } }
        } else if (pn < 16) { const int h = pn - 8; const float lgf = ret_log2g(h), lgb = ret_log2g(7 - h);
            EPI_ROWS(ai, m) { const int pos = ai * 128 + wr * 64 + m * 16 + fr; const int row = u.pm * 256 + pos; const float df = ex2((float)(255 - pos) * lgf), db = ex2((float)pos * lgb);
                EPI_COLS(bj, n) { const int d = bj * 128 + wc * 32 + n * 16 + fq * 4; const f32x4 k = acc[ai][bj][m][n];
                    *(u32x2*)(K2 + (size_t)row * D + h * 256 + d) = pk4(k); const size_t to = (((size_t)u.pm * 8 + h) * 256 + d) * 256 + pos;
#pragma unroll
                    for (int j = 0; j < 4; ++j) { KTf[to + j * 256] = f2bf(k[j] * df); KTb[to + j * 256] = f2bf(k[j] * db); } } }
        } else if (pn < 32) { const int h = (pn - 16) >> 1, half = (pn - 16) & 1;
            EPI_ROWS(ai, m) { const int pos = ai * 128 + wr * 64 + m * 16 + fr;
                EPI_COLS(bj, n) { const int e = half * 256 + bj * 128 + wc * 32 + n * 16 + fq * 4; const f32x4 v = acc[ai][bj][m][n];
                    bf16_t* p = B3 + (((size_t)u.pm * 8 + h) * 512 + e) * 768 + 512 + pos;
#pragma unroll
                    for (int j = 0; j < 4; ++j) p[j * 768] = f2bf(v[j]); } }
        } else {
            EPI_ROWS(ai, m) { const int row = u.pm * 256 + ai * 128 + wr * 64 + m * 16 + fr;
                EPI_COLS(bj, n) { const int col = (pn - 32) * 256 + bj * 128 + wc * 32 + n * 16 + fq * 4; f32x4 v = acc[ai][bj][m][n];
#pragma unroll
                    for (int j = 0; j < 4; ++j) v[j] = siluf(v[j]);
                    *(u32x2*)(SG + (size_t)row * 4096 + col) = pk4(v); } }
        }
    }
};
struct EpiRetS {
    bf16_t* A3;
    __device__ __forceinline__ void operator()(const Acc& acc, const Unit& u, int wr, int wc, int fr, int fq) const {
        const int h = u.pn; const float lgf = ret_log2g(h), lgb = ret_log2g(7 - h);
        EPI_ROWS(ai, m) { const int i = ai * 128 + wr * 64 + m * 16 + fr; const int row = u.pm * 256 + i;
            EPI_COLS(bj, n) { const int j0 = bj * 128 + wc * 32 + n * 16 + fq * 4; f32x4 v = acc[ai][bj][m][n];
#pragma unroll
                for (int j = 0; j < 4; ++j) { const int rel = i - (j0 + j); v[j] *= rel >= 0 ? ex2((float)rel * lgf) : ex2((float)(-rel) * lgb); }
                *(u32x2*)(A3 + ((size_t)row * 8 + h) * 768 + 512 + j0) = pk4(v); } }
    }
};
struct EpiRetKV {
    float* KVT;
    __device__ __forceinline__ void operator()(const Acc& acc, const Unit& u, int wr, int wc, int fr, int fq) const {
        const int half = u.pn & 1, hd = u.pn >> 1;
        float* base = KVT + (((size_t)u.pm * 16 + hd) * 512 + half * 256) * 256;
        EPI_ROWS(ai, m) { const int r = ai * 128 + wr * 64 + m * 16 + fr;
            EPI_COLS(bj, n) { const int c = bj * 128 + wc * 32 + n * 16 + fq * 4; *(f32x4*)(base + (size_t)r * 256 + c) = acc[ai][bj][m][n]; } }
    }
};
struct EpiRetOut {
    float* O2;
    __device__ __forceinline__ void operator()(const Acc& acc, const Unit& u, int wr, int wc, int fr, int fq) const {
        EPI_ROWS(ai, m) { const int row = u.pm * 256 + ai * 128 + wr * 64 + m * 16 + fr;
            EPI_COLS(bj, n) { const int c = u.pn * 256 + bj * 128 + wc * 32 + n * 16 + fq * 4; *(f32x4*)(O2 + (size_t)row * 4096 + c) = acc[ai][bj][m][n]; } }
    }
};

template <int DV, bool OUTBF>
__device__ __forceinline__ void attn_unit(LAS unsigned char* lds, const int tid, const bf16_t* q, int ldq, const bf16_t* k0, const bf16_t* k1, int ldk,
                                          const bf16_t* vt0, const bf16_t* vt1, int ldvt, int nt0, int nt1, bool band, int qpos0, int kpos0,
                                          bool has_sink, float sink_l2, void* o, int ldo) {
    constexpr int KT_BYTES = 64 * 144, VT_BYTES = DV * 136, BUF = KT_BYTES + VT_BYTES, NV = DV / 64, NDV = DV / 32;
    const int lane = tid & 63, w = tid >> 6, c32 = lane & 31, hi = lane >> 5, srow = tid >> 3, sch = tid & 7;
    bf16x8 qf[4];
#pragma unroll
    for (int ks = 0; ks < 4; ++ks) qf[ks] = *(const bf16x8*)(q + (size_t)(32 * w + c32) * ldq + ks * 16 + hi * 8);
    f32x16 oacc[NDV];
#pragma unroll
    for (int i = 0; i < NDV; ++i)
#pragma unroll
        for (int r = 0; r < 16; ++r) oacc[i][r] = 0.f;
    float m_run = -1e30f, l_run = 0.f;
    const int ntile = nt0 + nt1;
    u32x4 kreg, vreg[NV];
    { const bf16_t* kp = nt0 > 0 ? k0 : k1; const bf16_t* vp = nt0 > 0 ? vt0 : vt1;
      kreg = *(const u32x4*)(kp + (size_t)srow * ldk + sch * 8);
#pragma unroll
      for (int i = 0; i < NV; ++i) vreg[i] = *(const u32x4*)(vp + (size_t)(srow + 64 * i) * ldvt + sch * 8); }
#pragma unroll 1
    for (int t = 0; t < ntile; ++t) {
        LAS unsigned char* kb = lds + (t & 1) * BUF; LAS unsigned char* vb = kb + KT_BYTES;
        *(LAS u32x4*)(kb + srow * 144 + sch * 16) = kreg;
#pragma unroll
        for (int i = 0; i < NV; ++i) { LAS unsigned char* p = vb + (srow + 64 * i) * 136 + sch * 16; *(LAS u32x2*)p = (u32x2){vreg[i].x, vreg[i].y}; *(LAS u32x2*)(p + 8) = (u32x2){vreg[i].z, vreg[i].w}; }
        __syncthreads();
        if (t + 1 < ntile) { const int t1 = t + 1; const bf16_t* kp = t1 < nt0 ? k0 + (size_t)(t1 * 64) * ldk : k1 + (size_t)((t1 - nt0) * 64) * ldk;
            const bf16_t* vp = t1 < nt0 ? vt0 + t1 * 64 : vt1 + (t1 - nt0) * 64;
            kreg = *(const u32x4*)(kp + (size_t)srow * ldk + sch * 8);
#pragma unroll
            for (int i = 0; i < NV; ++i) vreg[i] = *(const u32x4*)(vp + (size_t)(srow + 64 * i) * ldvt + sch * 8); }
        f32x16 sacc[2];
#pragma unroll
        for (int a = 0; a < 2; ++a) {
#pragma unroll
            for (int r = 0; r < 16; ++r) sacc[a][r] = 0.f;
#pragma unroll
            for (int ks = 0; ks < 4; ++ks) { const bf16x8 kf = *(const LAS bf16x8*)(kb + (32 * a + c32) * 144 + ks * 32 + hi * 16); sacc[a] = __builtin_amdgcn_mfma_f32_32x32x16_bf16(kf, qf[ks], sacc[a], 0, 0, 0); }
        }
        if (band && t < nt0) { const int qp = qpos0 + 32 * w + c32;
#pragma unroll
            for (int a = 0; a < 2; ++a)
#pragma unroll
                for (int r = 0; r < 16; ++r) { const int kp = kpos0 + t * 64 + 32 * a + (r & 3) + 8 * (r >> 2) + 4 * hi; const int dlt = kp - qp; if (dlt > 128 || dlt < -128) sacc[a][r] = -INFINITY; } }
        float mx = -INFINITY;
#pragma unroll
        for (int a = 0; a < 2; ++a)
#pragma unroll
            for (int r = 0; r < 16; ++r) mx = fmaxf(mx, sacc[a][r]);
        mx = fmaxf(mx, __shfl_xor(mx, 32));
        const float mnew = fmaxf(m_run, mx), alpha = ex2(m_run - mnew); m_run = mnew;
        float ls = 0.f;
#pragma unroll
        for (int a = 0; a < 2; ++a)
#pragma unroll
            for (int r = 0; r < 16; ++r) { const float p = ex2(sacc[a][r] - mnew); sacc[a][r] = p; ls += p; }
        l_run = l_run * alpha + ls;
#pragma unroll
        for (int i = 0; i < NDV; ++i)
#pragma unroll
            for (int r = 0; r < 16; ++r) oacc[i][r] *= alpha;
        bf16x8 pf[4];
#pragma unroll
        for (int a = 0; a < 2; ++a)
#pragma unroll
            for (int jj = 0; jj < 2; ++jj) { u32x4 wv; wv.x = cvt_pk_bf16(sacc[a][8 * jj + 0], sacc[a][8 * jj + 1]); wv.y = cvt_pk_bf16(sacc[a][8 * jj + 2], sacc[a][8 * jj + 3]);
                wv.z = cvt_pk_bf16(sacc[a][8 * jj + 4], sacc[a][8 * jj + 5]); wv.w = cvt_pk_bf16(sacc[a][8 * jj + 6], sacc[a][8 * jj + 7]); pf[2 * a + jj] = __builtin_bit_cast(bf16x8, wv); }
#pragma unroll
        for (int i = 0; i < NDV; ++i)
#pragma unroll
            for (int j = 0; j < 4; ++j) { const LAS unsigned char* p = vb + (32 * i + c32) * 136 + (16 * j + 4 * hi) * 2; const u32x2 lo = *(const LAS u32x2*)p, hh = *(const LAS u32x2*)(p + 16);
                const u32x4 wv = (u32x4){lo.x, lo.y, hh.x, hh.y}; oacc[i] = __builtin_amdgcn_mfma_f32_32x32x16_bf16(__builtin_bit_cast(bf16x8, wv), pf[j], oacc[i], 0, 0, 0); }
    }
    float lt = l_run + __shfl_xor(l_run, 32);
    if (has_sink) lt += ex2(sink_l2 - m_run);
    const float inv = 1.f / lt;
    const int row = 32 * w + c32;
#pragma unroll
    for (int i = 0; i < NDV; ++i)
#pragma unroll
        for (int g = 0; g < 4; ++g) { const int col = 32 * i + 8 * g + 4 * hi; const f32x4 v = (f32x4){oacc[i][4 * g], oacc[i][4 * g + 1], oacc[i][4 * g + 2], oacc[i][4 * g + 3]} * inv;
            if (OUTBF) *(u32x2*)((bf16_t*)o + (size_t)row * ldo + col) = pk4(v); else *(f32x4*)((float*)o + (size_t)row * ldo + col) = v; }
    __syncthreads();
}

#define XB_TMO      128
#define XB_XCNT(j)  (256  + 64 * (j))
#define XB_XSUB(j)  (1280 + 64 * (j))
#define XB_XGEN(j)  (2304 + 64 * (j))
#define XB_TOP      3328
#define XB_TOPGEN   3392
#define XCD_BAR_WORDS 3456
#define XB_SPIN_CAP (1u << 18)
__device__ __forceinline__ unsigned xb_ld(unsigned* p)              { return __hip_atomic_load(p, __ATOMIC_RELAXED, __HIP_MEMORY_SCOPE_AGENT); }
__device__ __forceinline__ unsigned xb_add(unsigned* p, unsigned v) { return __hip_atomic_fetch_add(p, v, __ATOMIC_RELAXED, __HIP_MEMORY_SCOPE_AGENT); }
__device__ __forceinline__ unsigned xb_xcc_id() { return (unsigned)__builtin_amdgcn_s_getreg((3 << 11) | 20) & 0xFu; }
#define XB_SPIN(cond, bar) do { unsigned _sp = 0; while (cond) { __builtin_amdgcn_s_sleep(1); \
    if ((++_sp & 255u) == 0u) { if (xb_ld(&(bar)[XB_TMO])) break; if (_sp > XB_SPIN_CAP) { atomicAdd(&(bar)[XB_TMO], 1u); break; } } } } while (0)
struct XcdBarrier { unsigned* bar; unsigned x; volatile LAS unsigned* st; };
__device__ __forceinline__ XcdBarrier xcd_barrier_post(unsigned* bar, volatile LAS unsigned* st) {
    XcdBarrier b; b.bar = bar; b.x = xb_xcc_id(); b.st = st;
    if (threadIdx.x == 0) (void)xb_add(&bar[XB_XCNT(b.x)], 1u);
    return b;
}
__device__ __forceinline__ void xcd_barrier_complete(unsigned* bar, unsigned x, unsigned& nloc, unsigned& nx) {
    const unsigned G = gridDim.x * gridDim.y * gridDim.z;
    unsigned sum, cnt, mine, sp = 0u;
    for (;;) {
        sum = 0u; cnt = 0u; mine = 0u;
#pragma unroll
        for (unsigned j = 0; j < 16; ++j) { const unsigned c = xb_ld(&bar[XB_XCNT(j)]); sum += c; cnt += (c > 0u) ? 1u : 0u; mine = (j == x) ? c : mine; }
        if (sum == G) break;
        __builtin_amdgcn_s_sleep(1);
        if ((++sp & 255u) == 0u) { if (xb_ld(&bar[XB_TMO])) break; if (sp > XB_SPIN_CAP) { atomicAdd(&bar[XB_TMO], 1u); break; } }
    }
    nloc = mine > 0u ? mine : 1u; nx = cnt > 0u ? cnt : 1u;
}
__device__ __forceinline__ void xcd_barrier(const XcdBarrier& b) {
    asm volatile("s_waitcnt vmcnt(0)" ::: "memory");
    __syncthreads();
    if (threadIdx.x == 0) {
        unsigned* bar = b.bar;
        __builtin_amdgcn_s_waitcnt(0);
        unsigned nloc = b.st[0], nx = b.st[1];
        if (nloc == 0u) { xcd_barrier_complete(bar, b.x, nloc, nx); b.st[0] = nloc; b.st[1] = nx; }
        const unsigned old = xb_add(&bar[XB_XSUB(b.x)], 1u);
        const unsigned gen = old / nloc;
        if (old + 1u == (gen + 1u) * nloc) {
            __builtin_amdgcn_fence(__ATOMIC_RELEASE, "agent");
            asm volatile("s_waitcnt vmcnt(0)" ::: "memory");
            const unsigned og = xb_add(&bar[XB_TOP], 1u);
            const unsigned tg = og / nx;
            if (og + 1u == (tg + 1u) * nx) xb_add(&bar[XB_TOPGEN], 1u);
            else XB_SPIN(xb_ld(&bar[XB_TOPGEN]) == tg, bar);
            __builtin_amdgcn_fence(__ATOMIC_ACQUIRE, "agent");
            xb_add(&bar[XB_XGEN(b.x)], 1u);
            asm volatile("s_waitcnt vmcnt(0)" ::: "memory");
        } else {
            XB_SPIN(xb_ld(&bar[XB_XGEN(b.x)]) == gen, bar);
            __builtin_amdgcn_fence(__ATOMIC_ACQUIRE, "agent");
            asm volatile("s_waitcnt vmcnt(0)" ::: "memory");
        }
    }
    __syncthreads();
}

constexpr int NWAVES = 8, NTHR = 512;
constexpr int RING_BYTES = 131072, MISC_OFF = RING_BYTES + 320, LDS_BYTES = 147456;
constexpr int CW_BAR = 4096;
constexpr int NPHASE = 3 + 12 * DEPTH;

struct Args { const float* in[26]; float* out; unsigned char* ws; int ph_lo, ph_hi; };
enum { I_X = 0, I_C, I_CTX, I_CCTX, I_ADAW, I_ADAB, I_LNG, I_LNB, I_W1, I_W2, I_LIN, I_LCW, I_LCB, I_LGW, I_LGB, I_LLAM, I_LOUT, I_DQKV, I_DLAM, I_DSUB, I_DOUT, I_RQKVG, I_ROUT, I_SQKV, I_SSINK, I_SOUT };

__device__ __forceinline__ unsigned pk2(float lo, float hi) { return cvt_pk_bf16(lo, hi); }
__device__ __forceinline__ void tr_item(const float* W, int ldw, bf16_t* WT, int ldt, int k0, int n0, LAS float* scr, int lane) {
#pragma unroll 8
    for (int i = 0; i < 32; ++i) { const int kk = 2 * i + (lane >> 5); scr[kk * 33 + (lane & 31)] = W[(size_t)(k0 + kk) * ldw + n0 + (lane & 31)]; }
    asm volatile("s_waitcnt lgkmcnt(0)" ::: "memory");
    const int c = lane & 7;
#pragma unroll
    for (int j = 0; j < 4; ++j) { const int n = (lane >> 3) + 8 * j; const LAS float* s = scr + (8 * c) * 33 + n;
        u32x4 o; o.x = pk2(s[0 * 33], s[1 * 33]); o.y = pk2(s[2 * 33], s[3 * 33]); o.z = pk2(s[4 * 33], s[5 * 33]); o.w = pk2(s[6 * 33], s[7 * 33]);
        *(u32x4*)(WT + (size_t)(n0 + n) * ldt + k0 + 8 * c) = o; }
    asm volatile("s_waitcnt lgkmcnt(0)" ::: "memory");
}
__device__ __forceinline__ void tr_job(const float* W, int K, int N, bf16_t* WT, LAS float* scr, int lane, int gw, int NGW, int& base) {
    const int nblk = N / 32, nitems = (K / 64) * nblk;
    for (int it = ((gw - base) % NGW + NGW) % NGW; it < nitems; it += NGW) tr_item(W, N, WT, K, 64 * (it / nblk), 32 * (it % nblk), scr, lane);
    base += nitems;
}

__device__ __forceinline__ unsigned char* launder_ptr(unsigned char* p) { unsigned long long w = (unsigned long long)p; unsigned l = (unsigned)w, h = (unsigned)(w >> 32);
    asm volatile("" : "+v"(l), "+v"(h)); l = __builtin_amdgcn_readfirstlane(l); h = __builtin_amdgcn_readfirstlane(h); return (unsigned char*)(((unsigned long long)h << 32) | l); }
__device__ __forceinline__ const float* input_ptr(const Args& a, int k) { asm volatile("" : "+v"(k)); k = __builtin_amdgcn_readfirstlane(k); return a.in[k]; }
#define PHFN __device__ __forceinline__
PHFN void ph_lru_in(LAS unsigned char* lds, const int tid, unsigned char* ws, int G, int bid) {
    pg8::Order<MapPlain> S; S.init(R / 256, 16, G, bid, D, MapPlain{(const char*)(ws + WS_U), (const char*)(ws + W_LRU_IN), (size_t)256 * D * 2, (size_t)256 * D * 2});
    EpiLruIn E{(bf16_t*)(ws + X_GG), (float*)(ws + X_REC)};
    pg8::gemm_phase<EpiLruIn, pg8::Order<MapPlain>, true>(lds, tid, D, D, D, S, E);
}
PHFN void ph_lru_gate(LAS unsigned char* lds, const int tid, unsigned char* ws, const float* gb, int G, int bid) {
    pg8::Order<MapLruGate> S; S.init(R / 256, 32, G, bid, 256, MapLruGate{(const char*)(ws + X_XCB), (const char*)(ws + W_LRU_G)});
    EpiLruGate E{(const float*)(ws + X_XCF), gb, (const float*)(ws + WS_SP), (float*)(ws + X_AB), (float*)(ws + X_BB)};
    pg8::gemm_phase<EpiLruGate, pg8::Order<MapLruGate>, true>(lds, tid, 256, D, 256, S, E);
}
PHFN void ph_qkv(LAS unsigned char* lds, const int tid, unsigned char* ws, int swa, int G, int bid) {
    pg8::Order<MapPlain> S; S.init(R / 256, swa ? 12 : 24, G, bid, D, MapPlain{(const char*)(ws + WS_U), (const char*)(ws + (swa ? W_SWA_QKV : W_DIF_QKV)), (size_t)256 * D * 2, (size_t)256 * D * 2});
    EpiQKV E{(bf16_t*)(ws + X_Q1), (bf16_t*)(ws + X_K1), (bf16_t*)(ws + (swa ? X_VT3 : X_VT1)), swa ? 512 : 2048, swa ? 6 : 7, swa ? 8 : 16};
    pg8::gemm_phase<EpiQKV, pg8::Order<MapPlain>, true>(lds, tid, D, D, D, S, E);
}
PHFN void ph_ret_qkvg(LAS unsigned char* lds, const int tid, unsigned char* ws, int G, int bid) {
    pg8::Order<MapPlain> S; S.init(R / 256, 48, G, bid, D, MapPlain{(const char*)(ws + WS_U), (const char*)(ws + W_RET_QKVG), (size_t)256 * D * 2, (size_t)256 * D * 2});
    EpiRetQKVG E{(bf16_t*)(ws + X_Q2), (bf16_t*)(ws + X_K2), (bf16_t*)(ws + X_KTF), (bf16_t*)(ws + X_KTB), (bf16_t*)(ws + X_A3), (bf16_t*)(ws + X_B3), (bf16_t*)(ws + X_SG)};
    pg8::gemm_phase<EpiRetQKVG, pg8::Order<MapPlain>, true>(lds, tid, D, D, D, S, E);
}
PHFN void ph_ret_s(LAS unsigned char* lds, const int tid, unsigned char* ws, int G, int bid) {
    pg8::Order<MapRetS> S; S.init(R / 256, 8, G, bid, 256, MapRetS{(const char*)(ws + X_Q2), (const char*)(ws + X_K2)});
    EpiRetS E{(bf16_t*)(ws + X_A3)};
    pg8::gemm_phase<EpiRetS, pg8::Order<MapRetS>, true>(lds, tid, 256, D, D, S, E);
}
PHFN void ph_ret_kv(LAS unsigned char* lds, const int tid, unsigned char* ws, int G, int bid) {
    pg8::Order<MapRetKV> S; S.init(R / 256, 32, G, bid, 256, MapRetKV{(const char*)(ws + X_B3), (const char*)(ws + X_KTF), (const char*)(ws + X_KTB)});
    EpiRetKV E{(float*)(ws + X_KVT)};
    pg8::gemm_phase<EpiRetKV, pg8::Order<MapRetKV>, true>(lds, tid, 256, 768, 256, S, E);
}
PHFN void ph_ret_out(LAS unsigned char* lds, const int tid, unsigned char* ws, int G, int bid) {
    pg8::Order<MapRetOut> S; S.init(R / 256, 16, G, bid, 768, MapRetOut{(const char*)(ws + X_A3), (const char*)(ws + X_B3)});
    EpiRetOut E{(float*)(ws + X_O2)};
    pg8::gemm_phase<EpiRetOut, pg8::Order<MapRetOut>, true>(lds, tid, 768, 8 * 768, 768, S, E);
}
template <int K> PHFN void ph_resid(LAS unsigned char* lds, const int tid, unsigned char* ws, const bf16_t* A, const bf16_t* W, int nrows, const float* gate, int G, int bid) {
    OrderResid S{(const char*)A, (const char*)W, K, RL / 256, (nrows - RL) / 256, G, bid};
    EpiResid E{(const float*)(ws + WS_H), (float*)(ws + WS_T), gate, (float*)(ws + X_PARTK)};
    pg8::gemm_phase<EpiResid, OrderResid, true>(lds, tid, K, K, K, S, E);
}
PHFN void ph_up(LAS unsigned char* lds, const int tid, unsigned char* ws, int layer, int nrows, int G, int bid) {
    pg8::Order<MapPlain> S; S.init(nrows / 256, FF / 256, G, bid, D, MapPlain{(const char*)(ws + WS_U), (const char*)(ws + W_MLP1) + (size_t)layer * D * FF * 2, (size_t)256 * D * 2, (size_t)256 * D * 2});
    EpiMlpUp E{(bf16_t*)(ws + X_ACT)};
    pg8::gemm_phase<EpiMlpUp, pg8::Order<MapPlain>, true>(lds, tid, D, D, D, S, E);
}
PHFN void ph_attn_dif(LAS unsigned char* lds, const int tid, unsigned char* ws, int G, int bid) {
    const bf16_t* Q1 = (const bf16_t*)(ws + X_Q1); const bf16_t* K1 = (const bf16_t*)(ws + X_K1); const bf16_t* VT1 = (const bf16_t*)(ws + X_VT1); float* OD = (float*)(ws + X_OD);
#pragma unroll 1
    for (int u = bid; u < 1152; u += G) {
        int b, h, mm, qrow, nt0;
        if (u < 1024) { const int qb = u & 7; mm = (u >> 3) & 1; h = (u >> 4) & 15; b = u >> 8; qrow = b * SEQ + qb * 256; nt0 = 32; }
        else { const int v = u - 1024; mm = v & 1; h = (v >> 1) & 15; b = v >> 5; qrow = RL + b * CTX; nt0 = 0; }
        const int hc = h * 128 + mm * 64;
        const bf16_t* vt = VT1 + ((size_t)(b * 16 + h) * 128) * NTOK;
        attn_unit<128, false>(lds, tid, Q1 + (size_t)qrow * D + hc, D, K1 + (size_t)(b * SEQ) * D + hc, K1 + (size_t)(RL + b * CTX) * D + hc, D,
                              vt, vt + SEQ, NTOK, nt0, 4, false, 0, 0, false, 0.f, OD + (size_t)mm * R * D + (size_t)qrow * D + h * 128, D);
    }
}
PHFN void ph_attn_swa(LAS unsigned char* lds, const int tid, unsigned char* ws, const float* sink, int G, int bid) {
    const bf16_t* Q3 = (const bf16_t*)(ws + X_Q3); const bf16_t* K3 = (const bf16_t*)(ws + X_K3); const bf16_t* VT3 = (const bf16_t*)(ws + X_VT3); bf16_t* AO = (bf16_t*)(ws + X_AO);
#pragma unroll 1
    for (int u = bid; u < 1024; u += G) {
        const int qb = u & 7, hq = (u >> 3) & 31, b = u >> 8, kvh = hq >> 2; const int qrow = b * SEQ + qb * 256;
        const int klo = qb * 256 - 128 < 0 ? 0 : qb * 256 - 128, khi = qb * 256 + 384 > SEQ ? SEQ : qb * 256 + 384;
        const bf16_t* vt = VT3 + ((size_t)(b * 8 + kvh) * 64) * NTOK;
        attn_unit<64, true>(lds, tid, Q3 + (size_t)qrow * D + hq * 64, D, K3 + (size_t)(b * SEQ + klo) * 512 + kvh * 64, K3 + (size_t)(RL + b * CTX) * 512 + kvh * 64, 512,
                            vt + klo, vt + SEQ, NTOK, (khi - klo) / 64, 4, true, qb * 256, klo, true, sink[hq] * LOG2E, AO + (size_t)qrow * D + hq * 64, D);
    }
}


__device__ __forceinline__ int phase_group(int ph) {
    if (ph < 1) return 0; if (ph < 3) return 1;
    const int layer = (ph - 3) / 12, k = (ph - 3) % 12;
    if (k == 7) return 14; if (k == 8 || k == 11) return 15; if (k == 9) return 16; if (k == 10) return 17;
    if (layer == 0) return k == 0 ? 2 : (k == 2 ? 4 : 3);
    if (layer == 1) return 5 + k;
    if (layer == 2) return k == 0 ? 8 : (k <= 2 ? 9 : (k == 4 ? 11 : 10));
    return 12 + k;
}
#ifdef DUP_GROUP
#define REPLOOP(k) _Pragma("unroll 1") for (int rep_ = 0, nrep_ = (phase_group(k) == DUP_GROUP ? 2 : 1); rep_ < nrep_; ++rep_)
#define NBAR (DUP_GROUP == 18 ? 2 : 1)
#else
#define REPLOOP(k)
#define NBAR 1
#endif
__global__ void __launch_bounds__(NTHR, 2) fwd(Args args) {
    extern __shared__ __attribute__((aligned(16))) unsigned char lds_raw[];
    LAS unsigned char* lds = (LAS unsigned char*)lds_raw;
    for (int u = threadIdx.x; u < (LDS_BYTES - RING_BYTES) / 4; u += NTHR) ((LAS unsigned*)(lds + RING_BYTES))[u] = 0u;
    __syncthreads();
    (void)xcd_barrier_post((unsigned*)(args.ws + WS_CTL) + CW_BAR, (volatile LAS unsigned*)(lds + MISC_OFF) + 8);
#ifdef PH_TEST
    const int lo = PH_TEST, hi = PH_TEST + 1;
#else
    const int lo = args.ph_lo, hi = args.ph_hi;
#endif
#define IN(k) (lo <= (k) && (k) < hi)
#define PH_BEGIN() int tid = threadIdx.x, bid = blockIdx.x, G = gridDim.x; unsigned char* ws = launder_ptr(args.ws); \
    asm volatile("" : "+v"(tid), "+v"(bid), "+v"(G)); bid = __builtin_amdgcn_readfirstlane(bid); G = __builtin_amdgcn_readfirstlane(G); \
    const int lane = tid & 63, wave = __builtin_amdgcn_readfirstlane(tid >> 6); \
    const int gw = bid * NWAVES + wave, NGW = G * NWAVES; const size_t gtid = (size_t)bid * NTHR + tid, NGT = (size_t)G * NTHR; \
    (void)lane; (void)wave; (void)gw; (void)NGW; (void)gtid; (void)NGT; \
    float* MOD = (float*)(ws + WS_MOD); float* SP = (float*)(ws + WS_SP); float* PART = (float*)(ws + WS_PART); \
    float* Hs = (float*)(ws + WS_H); float* Ts = (float*)(ws + WS_T); bf16_t* Us = (bf16_t*)(ws + WS_U); \
    (void)MOD; (void)SP; (void)PART; (void)Hs; (void)Ts; (void)Us;
#define INP(k) input_ptr(args, (k))
#define SEAM(k) do { if ((k) + 1 < hi) { unsigned char* wsb = launder_ptr(args.ws); XcdBarrier bar; bar.bar = (unsigned*)(wsb + WS_CTL) + CW_BAR; bar.x = xb_xcc_id(); \
    bar.st = (volatile LAS unsigned*)(lds + MISC_OFF) + 8; for (int nb_ = 0; nb_ < NBAR; ++nb_) xcd_barrier(bar); } } while (0)

    if (IN(0)) { REPLOOP(0) { PH_BEGIN();
        LAS float* sl = (LAS float*)(lds + 81920);
        for (int i = tid; i < 5 * D; i += NTHR) { const int r = i >> 11, k = i & (D - 1); const float v = r < 4 ? INP(I_C)[r * D + k] : INP(I_CCTX)[k]; sl[i] = siluf(v); }
        __syncthreads();
        for (int task = gw; task < 4 * 8 * 48; task += NGW) {
            const int cc = task % 48, ks = (task / 48) & 7, l = task / 384; const int n0 = cc * 256 + lane * 4;
            const float* wp = INP(I_ADAW) + ((size_t)l * D + ks * 256) * MODW + n0;
            f32x4 a0 = {0, 0, 0, 0}, a1 = a0, a2 = a0, a3 = a0, a4 = a0;
#pragma unroll 8
            for (int k = 0; k < 256; ++k) { const f32x4 wv = *(const f32x4*)(wp + (size_t)k * MODW); const int kk = ks * 256 + k;
                a0 += wv * sl[kk]; a1 += wv * sl[D + kk]; a2 += wv * sl[2 * D + kk]; a3 += wv * sl[3 * D + kk]; a4 += wv * sl[4 * D + kk]; }
            float* pp = PART + ((size_t)(ks * 4 + l) * 5) * MODW + n0;
            *(f32x4*)(pp) = a0; *(f32x4*)(pp + MODW) = a1; *(f32x4*)(pp + 2 * MODW) = a2; *(f32x4*)(pp + 3 * MODW) = a3; *(f32x4*)(pp + 4 * MODW) = a4;
        }
        LAS float* scr = (LAS float*)(lds + wave * 8448);
        int base = 0;
        tr_job(INP(I_LIN), D, 4096, (bf16_t*)(ws + W_LRU_IN), scr, lane, gw, NGW, base);
        {
            const int nitems = 64 * 16;
            for (int it = ((gw - base) % NGW + NGW) % NGW; it < nitems; it += NGW) { const int sb = it >> 4, kb = (it >> 2) & 3, nb = it & 3;
                const int half = sb & 1, blk = (sb >> 1) & 7, g = (sb >> 4) & 1, dir = sb >> 5;
                const float* src = INP(I_LGW) + (size_t)(((dir * 2 + g) * 8 + blk)) * 65536 + half * 128;
                bf16_t* dst = (bf16_t*)(ws + W_LRU_G) + ((size_t)(((dir * 8 + blk) * 2 + half) * 256 + g * 128)) * 256;
                tr_item(src, 256, dst, 256, 64 * kb, 32 * nb, scr, lane); }
            base += nitems;
        }
        tr_job(INP(I_LOUT), D, D, (bf16_t*)(ws + W_LRU_OUT), scr, lane, gw, NGW, base);
        tr_job(INP(I_DQKV), D, 6144, (bf16_t*)(ws + W_DIF_QKV), scr, lane, gw, NGW, base);
        tr_job(INP(I_DOUT), D, D, (bf16_t*)(ws + W_DIF_OUT), scr, lane, gw, NGW, base);
        tr_job(INP(I_RQKVG), D, 12288, (bf16_t*)(ws + W_RET_QKVG), scr, lane, gw, NGW, base);
        tr_job(INP(I_ROUT), 4096, D, (bf16_t*)(ws + W_RET_OUT), scr, lane, gw, NGW, base);
        tr_job(INP(I_SQKV), D, 3072, (bf16_t*)(ws + W_SWA_QKV), scr, lane, gw, NGW, base);
        tr_job(INP(I_SOUT), D, D, (bf16_t*)(ws + W_SWA_OUT), scr, lane, gw, NGW, base);
#pragma unroll 1
        for (int l = 0; l < DEPTH; ++l) {
            tr_job(INP(I_W1) + (size_t)l * D * FF, D, FF, (bf16_t*)(ws + W_MLP1) + (size_t)l * D * FF, scr, lane, gw, NGW, base);
            tr_job(INP(I_W2) + (size_t)l * D * FF, FF, D, (bf16_t*)(ws + W_MLP2) + (size_t)l * D * FF, scr, lane, gw, NGW, base);
        }
        __syncthreads();
        } SEAM(0);
    }
    if (IN(1)) { REPLOOP(1) { PH_BEGIN();
        for (size_t i = gtid; i < (size_t)4 * 5 * MODW; i += NGT) { const int n = (int)(i % MODW); const int l = (int)(i / (5 * MODW));
            float s = INP(I_ADAB)[l * MODW + n];
#pragma unroll
            for (int ks = 0; ks < 8; ++ks) s += PART[(size_t)ks * 4 * 5 * MODW + i];
            MOD[i] = s; }
        for (size_t i = gtid; i < 2 * D; i += NGT) { const float lam = INP(I_LLAM)[i]; const float x = ex2(-lam * LOG2E);
            const float sp = x < 0.05f ? x * (1.f + x * (-0.5f + x * (1.f / 3.f + x * (-0.25f + x * (0.2f - x * (1.f / 6.f)))))) : logf(1.f + x);
            SP[i] = -8.f * sp; }
        } SEAM(1);
    }
    if (IN(2)) { REPLOOP(2) { PH_BEGIN();
        for (size_t i = gtid; i < (size_t)R * (D / 4); i += NGT) { const int row = (int)(i >> 9), c4 = (int)(i & 511) * 4;
            const f32x4 v = row < RL ? *(const f32x4*)(INP(I_X) + (size_t)row * D + c4) : *(const f32x4*)(INP(I_CTX) + (size_t)(row - RL) * D + c4);
            const float* mp = MOD + (size_t)mod_row(row) * MODW; const f32x4 sh = *(const f32x4*)(mp + c4), sc = *(const f32x4*)(mp + D + c4);
            *(f32x4*)(Hs + (size_t)row * D + c4) = v; *(u32x2*)(Us + (size_t)row * D + c4) = pk4(v * (sc + 1.f) + sh); }
        } SEAM(2);
    }

#pragma unroll 1
    for (int layer = 0; layer < DEPTH; ++layer) {
        const int Lb = 3 + 12 * layer;
        const int nrows = layer == DEPTH - 1 ? RL : R;
#define LAYER_VARS() const float* modl = MOD + (size_t)layer * 5 * MODW; (void)modl; \
        const bf16_t* YIN = (const bf16_t*)(ws + (layer == 0 ? X_YIN : layer == 1 ? X_DO : layer == 2 ? X_RO : X_AO)); (void)YIN; \
        const bf16_t* WOUT = (const bf16_t*)(ws + (layer == 0 ? W_LRU_OUT : layer == 1 ? W_DIF_OUT : layer == 2 ? W_RET_OUT : W_SWA_OUT)); (void)WOUT;

        if (layer == 0) {
#define LRU_VARS() bf16_t* GG = (bf16_t*)(ws + X_GG); float* REC = (float*)(ws + X_REC); bf16_t* XCB = (bf16_t*)(ws + X_XCB); float* XCF = (float*)(ws + X_XCF); \
            float* AB = (float*)(ws + X_AB); float* BB = (float*)(ws + X_BB); float* CAR = (float*)(ws + X_CARRY); bf16_t* YO = (bf16_t*)(ws + X_YIN); \
            (void)GG; (void)REC; (void)XCB; (void)XCF; (void)AB; (void)BB; (void)CAR; (void)YO;
            if (IN(Lb + 0)) { REPLOOP(Lb + 0) { PH_BEGIN(); ph_lru_in(lds, tid, ws, G, bid); } SEAM(Lb + 0); }
            if (IN(Lb + 1)) { REPLOOP(Lb + 1) { PH_BEGIN(); LRU_VARS();
                const float* cw = INP(I_LCW); const float* cb = INP(I_LCB);
                for (size_t i = gtid; i < (size_t)R * (D / 4); i += NGT) { const int row = (int)(i >> 9), c4 = (int)(i & 511) * 4;
                    const int t = row < RL ? (row & (SEQ - 1)) : ((row - RL) & (CTX - 1)), len = row < RL ? SEQ : CTX;
                    f32x4 a = *(const f32x4*)(cb + c4);
#pragma unroll
                    for (int k = 0; k < 4; ++k) { const int tt = t + k - 2; if (tt >= 0 && tt < len) a += *(const f32x4*)(cw + k * D + c4) * *(const f32x4*)(REC + (size_t)(row + k - 2) * D + c4); }
                    *(f32x4*)(XCF + (size_t)row * D + c4) = a; *(u32x2*)(XCB + (size_t)row * D + c4) = pk4(a); }
                } SEAM(Lb + 1);
            }
            if (IN(Lb + 2)) { REPLOOP(Lb + 2) { PH_BEGIN(); ph_lru_gate(lds, tid, ws, INP(I_LGB), G, bid); } SEAM(Lb + 2); }
            if (IN(Lb + 3)) { REPLOOP(Lb + 3) { PH_BEGIN(); LRU_VARS();
                for (int task = gw; task < 2 * 4 * 36 * 32; task += NGW) {
                    const int g = task & 31, c = (task >> 5) % 36, b = ((task >> 5) / 36) & 3, dir = (task >> 5) / 144; const int ch = g * 64 + lane;
                    int row0, stp;
                    if (dir == 0) { row0 = c < 4 ? RL + b * CTX + 64 * c : b * SEQ + 64 * (c - 4); stp = 1; }
                    else { row0 = c < 4 ? RL + b * CTX + 255 - 64 * c : b * SEQ + 2047 - 64 * (c - 4); stp = -1; }
                    const float* ap = AB + ((size_t)dir * R + row0) * D + ch; const float* bp = BB + ((size_t)dir * R + row0) * D + ch; const long st = (long)stp * D;
                    float pa = 1.f, h = 0.f;
#pragma unroll 8
                    for (int s = 0; s < 64; ++s) { const float a = ap[s * st], bb = bp[s * st]; pa *= a; h = a * h + bb; }
                    float* cp = CAR + (((size_t)(dir * 4 + b) * 36 + c) * 2) * D + ch; cp[0] = pa; cp[D] = h;
                }
                } SEAM(Lb + 3);
            }
            if (IN(Lb + 4)) { REPLOOP(Lb + 4) { PH_BEGIN(); LRU_VARS();
                LAS float* hf = (LAS float*)(lds + wave * 16384);
                for (int task = gw; task < 4 * 36 * 32; task += NGW) {
                    const int g = task & 31, n = (task >> 5) % 36, b = (task >> 5) / 36; const int ch = g * 64 + lane;
                    const int rowa = n < 4 ? RL + b * CTX + 64 * n : b * SEQ + 64 * (n - 4);
                    const int cf = n, cbk = n < 4 ? 3 - n : 4 + (31 - (n - 4));
                    float h = 0.f;
                    { const float* cp = CAR + ((size_t)(0 * 4 + b) * 36 * 2) * D + ch; for (int c = 0; c < cf; ++c) h = cp[(size_t)(c * 2) * D] * h + cp[(size_t)(c * 2 + 1) * D]; }
                    { const float* ap = AB + ((size_t)rowa) * D + ch; const float* bp = BB + ((size_t)rowa) * D + ch;
#pragma unroll 8
                      for (int s = 0; s < 64; ++s) { h = ap[(size_t)s * D] * h + bp[(size_t)s * D]; hf[s * 64 + lane] = h; } }
                    h = 0.f;
                    { const float* cp = CAR + ((size_t)(1 * 4 + b) * 36 * 2) * D + ch; for (int c = 0; c < cbk; ++c) h = cp[(size_t)(c * 2) * D] * h + cp[(size_t)(c * 2 + 1) * D]; }
                    { const float* ap = AB + ((size_t)R + rowa) * D + ch; const float* bp = BB + ((size_t)R + rowa) * D + ch;
#pragma unroll 8
                      for (int s = 63; s >= 0; --s) { h = ap[(size_t)s * D] * h + bp[(size_t)s * D]; const size_t o = (size_t)(rowa + s) * D + ch; YO[o] = f2bf(bf2f(GG[o]) * (hf[s * 64 + lane] + h)); } }
                }
                } SEAM(Lb + 4);
            }
        } else if (layer == 1) {
            if (IN(Lb + 0)) { REPLOOP(Lb + 0) { PH_BEGIN(); ph_qkv(lds, tid, ws, 0, G, bid); } SEAM(Lb + 0); }
            if (IN(Lb + 1)) { REPLOOP(Lb + 1) { PH_BEGIN(); ph_attn_dif(lds, tid, ws, G, bid); } SEAM(Lb + 1); }
            if (IN(Lb + 2)) { REPLOOP(Lb + 2) { PH_BEGIN(); float* OD = (float*)(ws + X_OD); bf16_t* DO = (bf16_t*)(ws + X_DO);
                const float* dl = INP(I_DLAM); const float lam_init = 0.8f - 0.6f * 0.7408182206817179f;
                const float s1 = wave_sum(dl[lane] * dl[64 + lane]), s2 = wave_sum(dl[128 + lane] * dl[192 + lane]);
                const float lamf = expf(s1) - expf(s2) + lam_init;
                const f32x4 sub = *(const f32x4*)(INP(I_DSUB) + ((lane & 31) * 4)) * (1.f - lam_init);
                for (int row = gw; row < R; row += NGW) {
#pragma unroll
                    for (int j = 0; j < 8; ++j) { const size_t o = (size_t)row * D + j * 256 + lane * 4; const f32x4 v = *(const f32x4*)(OD + o) - *(const f32x4*)(OD + (size_t)R * D + o) * lamf;
                        float ss = (v[0] * v[0] + v[1] * v[1]) + (v[2] * v[2] + v[3] * v[3]);
#pragma unroll
                        for (int x = 1; x < 32; x <<= 1) ss += __shfl_xor(ss, x);
                        const float rs = 1.f / sqrtf(ss * (1.f / 128.f) + LN_EPS);
                        *(u32x2*)(DO + o) = pk4(v * rs * sub); }
                }
                } SEAM(Lb + 2);
            }
        } else if (layer == 2) {
            if (IN(Lb + 0)) { REPLOOP(Lb + 0) { PH_BEGIN(); ph_ret_qkvg(lds, tid, ws, G, bid); } SEAM(Lb + 0); }
            if (IN(Lb + 1)) { REPLOOP(Lb + 1) { PH_BEGIN(); ph_ret_s(lds, tid, ws, G, bid); } SEAM(Lb + 1); }
            if (IN(Lb + 2)) { REPLOOP(Lb + 2) { PH_BEGIN(); ph_ret_kv(lds, tid, ws, G, bid); } SEAM(Lb + 2); }
            if (IN(Lb + 3)) { REPLOOP(Lb + 3) { PH_BEGIN(); bf16_t* B3 = (bf16_t*)(ws + X_B3); float* KVT = (float*)(ws + X_KVT);
                for (size_t i = gtid; i < (size_t)64 * 32768; i += NGT) { const int e4 = (int)(i & 32767), hd = (int)(i >> 15) & 15, b = (int)(i >> 19);
                    const int h = hd >> 1, dir = hd & 1; const int dv = e4 >> 6, dk = (e4 & 63) * 4;
                    const float cdec = ex2(256.f * ret_log2g(dir ? 7 - h : h));
                    f32x4 acc = {0.f, 0.f, 0.f, 0.f};
#pragma unroll 1
                    for (int s = 0; s < 9; ++s) { const int pm = s == 0 ? 32 + b : (dir == 0 ? b * 8 + (s - 1) : b * 8 + (8 - s));
                        *(u32x2*)(B3 + (((size_t)pm * 8 + h) * 512 + dv) * 768 + dir * 256 + dk) = pk4(acc);
                        acc = acc * cdec + *(const f32x4*)(KVT + (((size_t)pm * 16 + hd) * 512 + dv) * 256 + dk); }
                }
                } SEAM(Lb + 3);
            }
            if (IN(Lb + 4)) { REPLOOP(Lb + 4) { PH_BEGIN(); ph_ret_out(lds, tid, ws, G, bid); } SEAM(Lb + 4); }
            if (IN(Lb + 5)) { REPLOOP(Lb + 5) { PH_BEGIN(); float* O2 = (float*)(ws + X_O2); bf16_t* RO = (bf16_t*)(ws + X_RO); bf16_t* SG = (bf16_t*)(ws + X_SG);
                for (int row = gw; row < R; row += NGW) {
#pragma unroll
                    for (int hh = 0; hh < 8; ++hh) { const size_t o = (size_t)row * 4096 + hh * 512 + lane * 4; const f32x4 v0 = *(const f32x4*)(O2 + o), v1 = *(const f32x4*)(O2 + o + 256);
                        const float ss = wave_sum((v0[0] * v0[0] + v0[1] * v0[1]) + (v0[2] * v0[2] + v0[3] * v0[3]) + (v1[0] * v1[0] + v1[1] * v1[1]) + (v1[2] * v1[2] + v1[3] * v1[3]));
                        const float rs = 1.f / sqrtf(ss * (1.f / 512.f) + LN_EPS);
                        const u32x2 g0 = *(const u32x2*)(SG + o), g1 = *(const u32x2*)(SG + o + 256);
                        f32x4 ga, gb2; ga[0] = __uint_as_float(g0.x << 16); ga[1] = __uint_as_float(g0.x & 0xffff0000u); ga[2] = __uint_as_float(g0.y << 16); ga[3] = __uint_as_float(g0.y & 0xffff0000u);
                        gb2[0] = __uint_as_float(g1.x << 16); gb2[1] = __uint_as_float(g1.x & 0xffff0000u); gb2[2] = __uint_as_float(g1.y << 16); gb2[3] = __uint_as_float(g1.y & 0xffff0000u);
                        *(u32x2*)(RO + o) = pk4(v0 * rs * ga); *(u32x2*)(RO + o + 256) = pk4(v1 * rs * gb2); }
                }
                } SEAM(Lb + 5);
            }
        } else {
            if (IN(Lb + 0)) { REPLOOP(Lb + 0) { PH_BEGIN(); ph_qkv(lds, tid, ws, 1, G, bid); } SEAM(Lb + 0); }
            if (IN(Lb + 1)) { REPLOOP(Lb + 1) { PH_BEGIN(); ph_attn_swa(lds, tid, ws, INP(I_SSINK), G, bid); } SEAM(Lb + 1); }
        }

        if (IN(Lb + 7)) { REPLOOP(Lb + 7) { PH_BEGIN(); LAYER_VARS(); if (layer == 2) ph_resid<4096>(lds, tid, ws, YIN, WOUT, nrows, modl + 2 * D, G, bid); else ph_resid<D>(lds, tid, ws, YIN, WOUT, nrows, modl + 2 * D, G, bid); } SEAM(Lb + 7); }
#pragma unroll 1
        for (int which = 0; which < 2; ++which) {
            if (which == 1) {
                if (IN(Lb + 9)) { REPLOOP(Lb + 9) { PH_BEGIN(); ph_up(lds, tid, ws, layer, nrows, G, bid); } SEAM(Lb + 9); }
                if (IN(Lb + 10)) { REPLOOP(Lb + 10) { PH_BEGIN(); LAYER_VARS(); ph_resid<FF>(lds, tid, ws, (const bf16_t*)(ws + X_ACT), (const bf16_t*)(ws + W_MLP2) + (size_t)layer * D * FF, nrows, modl + 5 * D, G, bid); } SEAM(Lb + 10); }
            }
            const int pid = Lb + (which == 0 ? 8 : 11);
            if (IN(pid)) { REPLOOP(pid) { PH_BEGIN(); LAYER_VARS();
                const float* lg = INP(I_LNG) + (size_t)(layer * 2 + which) * D; const float* lb = INP(I_LNB) + (size_t)(layer * 2 + which) * D;
                const bool fin = (layer == DEPTH - 1 && which == 1);
                const float* mbase = which == 0 ? modl + 3 * D : modl + 5 * MODW;
                for (int t = gw; t < 2048; t += NGW) {
                  int r0, nr, rc = -1;
                  if (nrows == RL) { r0 = 4 * t; nr = 4; } else if (t < 1024) { rc = RL + t; r0 = 3 * t; nr = 3; } else { r0 = 3072 + (t - 1024) * 5; nr = 5; }
#pragma unroll 1
                  for (int q = (rc >= 0 ? -1 : 0); q < nr; ++q) { const int row = q < 0 ? rc : r0 + q;
                    const float* tp = Ts + (size_t)row * D + lane * 4;
                    f32x4 v[8]; float s = 0.f;
if (row < RL) {
#pragma unroll
                        for (int j = 0; j < 8; ++j) v[j] = *(const f32x4*)(tp + 256 * j);
                    } else {
                        const float* hp0 = Hs + (size_t)row * D + lane * 4; const float* gp = modl + 4 * MODW + (which == 0 ? 2 : 5) * D + lane * 4;
                        const float* pk = (const float*)(ws + X_PARTK) + (size_t)(row - RL) * D + lane * 4;
#pragma unroll
                        for (int j = 0; j < 8; ++j) { f32x4 a = *(const f32x4*)(pk + 256 * j);
#pragma unroll
                            for (int ks = 1; ks < 8; ++ks) a += *(const f32x4*)(pk + (size_t)ks * RC * D + 256 * j);
                            v[j] = *(const f32x4*)(hp0 + 256 * j) * ALPHA + *(const f32x4*)(gp + 256 * j) * a; }
                    }
#pragma unroll
                    for (int j = 0; j < 8; ++j) s += (v[j][0] + v[j][1]) + (v[j][2] + v[j][3]);
                    const float mean = wave_sum(s) * (1.f / D); float s2 = 0.f;
#pragma unroll
                    for (int j = 0; j < 8; ++j) { v[j] = v[j] - mean; s2 += (v[j][0] * v[j][0] + v[j][1] * v[j][1]) + (v[j][2] * v[j][2] + v[j][3] * v[j][3]); }
                    const float rstd = 1.f / sqrtf(wave_sum(s2) * (1.f / D) + LN_EPS);
                    const float* mp = mbase + (size_t)mod_row(row) * MODW;
                    float* hp = (fin ? args.out : Hs) + (size_t)row * D + lane * 4;
#pragma unroll
                    for (int j = 0; j < 8; ++j) { const int c = lane * 4 + 256 * j; const f32x4 y = v[j] * rstd * *(const f32x4*)(lg + c) + *(const f32x4*)(lb + c);
                        *(f32x4*)(hp + 256 * j) = y;
                        if (!fin) { const f32x4 sh = *(const f32x4*)(mp + c), sc = *(const f32x4*)(mp + D + c); *(u32x2*)(Us + (size_t)row * D + c) = pk4(y * (sc + 1.f) + sh); } }
                  }
                }
                } SEAM(pid);
            }
        }
    }
#undef IN
#undef SEAM
}

__global__ void marker_kernel(float* out, int n, float v) { const int i = blockIdx.x * blockDim.x + threadIdx.x; if (i < n) out[i] = v; }

static bool phase_used(int ph) {
    if (ph < 3) return true;
    const int layer = (ph - 3) / 12, k = (ph - 3) % 12;
    if (k >= 7) return true;
    const int nmix[4] = {5, 3, 6, 2};
    return k < nmix[layer];
}

extern "C" void kernel_launch(void* const* d_in, const int* in_sizes, int n_in, void* d_out, int out_size, void* d_ws, size_t ws_size, hipStream_t stream) {
    static int grid = 0;
    if (grid == 0) {
        int dev = 0, cus = 0;
        if (hipGetDevice(&dev) != hipSuccess || hipDeviceGetAttribute(&cus, hipDeviceAttributeMultiprocessorCount, dev) != hipSuccess) { grid = -1; }
        else if (hipFuncSetAttribute((const void*)fwd, hipFuncAttributeMaxDynamicSharedMemorySize, LDS_BYTES) != hipSuccess) { fprintf(stderr, "kernel_launch: hipFuncSetAttribute failed\n"); grid = -1; }
        else { int per_cu = 0; (void)hipOccupancyMaxActiveBlocksPerMultiprocessor(&per_cu, (const void*)fwd, NTHR, LDS_BYTES); (void)hipGetLastError(); grid = cus; }
    }
    if (grid < 0 || n_in != 26 || out_size != RL * D || ws_size < WS_END) {
        fprintf(stderr, "kernel_launch: bad configuration (grid %d n_in %d out %d ws %zu need %zu)\n", grid, n_in, out_size, ws_size, (size_t)WS_END);
        hipLaunchKernelGGL(marker_kernel, dim3((out_size + 255) / 256), dim3(256), 0, stream, (float*)d_out, out_size, ws_size < WS_END ? 1000.f : 3000.f);
        return;
    }
    (void)hipMemsetAsync((char*)d_ws + WS_CTL, 0, CTL_BYTES, stream);
    Args a{};
    for (int i = 0; i < 26; ++i) a.in[i] = (const float*)d_in[i];
    a.out = (float*)d_out; a.ws = (unsigned char*)d_ws;
#if MK_MULTI
    for (int ph = 0; ph < NPHASE; ++ph) { if (!phase_used(ph)) continue; a.ph_lo = ph; a.ph_hi = ph + 1; hipLaunchKernelGGL(fwd, dim3(grid), dim3(NTHR), LDS_BYTES, stream, a); }
#else
    a.ph_lo = 0; a.ph_hi = NPHASE;
    hipLaunchKernelGGL(fwd, dim3(grid), dim3(NTHR), LDS_BYTES, stream, a);
#endif
}
```

```cpp
#include <hip/hip_runtime.h>
#include <cstdio>
#include <cstdint>

#ifndef MK_MULTI
#define MK_MULTI 0
#endif

#define LAS __attribute__((address_space(3)))
#define GAS __attribute__((address_space(1)))
typedef unsigned short bf16_t;
typedef short bf16x8 __attribute__((ext_vector_type(8)));
typedef float f32x4 __attribute__((ext_vector_type(4)));
typedef float f32x2 __attribute__((ext_vector_type(2)));
typedef float f32x16 __attribute__((ext_vector_type(16)));
typedef unsigned u32x4 __attribute__((ext_vector_type(4)));
typedef unsigned u32x2 __attribute__((ext_vector_type(2)));

constexpr int D = 2048, NB = 4, SEQ = 2048, CTX = 256, DEPTH = 4, FF = 8192;
constexpr int RL = NB * SEQ, RC = NB * CTX, R = RL + RC;
constexpr int NTOK = SEQ + CTX;
constexpr float LN_EPS = 1e-5f;
constexpr float ALPHA = 1.681792830507429f;
constexpr float LOG2E = 1.4426950408889634f;
constexpr int MODW = 6 * D;

constexpr size_t MiB = (size_t)1 << 20;
constexpr size_t WS_CTL = 0, CTL_BYTES = 1 * MiB;
constexpr size_t WS_MOD = 1 * MiB;
constexpr size_t WS_SP = 2 * MiB;
constexpr size_t WS_PART = 3 * MiB;
constexpr size_t WS_W = 11 * MiB;
constexpr size_t W_LRU_IN = WS_W, W_LRU_G = WS_W + 16 * MiB, W_LRU_OUT = WS_W + 20 * MiB, W_DIF_QKV = WS_W + 28 * MiB, W_DIF_OUT = WS_W + 52 * MiB,
                 W_RET_QKVG = WS_W + 60 * MiB, W_RET_OUT = WS_W + 108 * MiB, W_SWA_QKV = WS_W + 124 * MiB, W_SWA_OUT = WS_W + 136 * MiB,
                 W_MLP1 = WS_W + 144 * MiB, W_MLP2 = WS_W + 272 * MiB;
constexpr size_t WS_H = 411 * MiB, WS_T = 483 * MiB, WS_U = 555 * MiB, WS_X = 591 * MiB;
constexpr size_t X_ACT = WS_X;
constexpr size_t X_PC = WS_X + 36 * MiB, X_HL = WS_X + 144 * MiB, X_CIN = WS_X + 508 * MiB;
constexpr size_t X_GG = WS_X, X_REC = WS_X + 36 * MiB, X_XCB = WS_X + 108 * MiB, X_XCF = WS_X + 144 * MiB, X_AB = WS_X + 216 * MiB, X_BB = WS_X + 360 * MiB,
                 X_CARRY = WS_X + 504 * MiB, X_YIN = WS_X + 512 * MiB;
constexpr size_t X_Q1 = WS_X, X_K1 = WS_X + 36 * MiB, X_VT1 = WS_X + 72 * MiB, X_OD = WS_X + 108 * MiB, X_DO = WS_X + 252 * MiB;
constexpr size_t X_Q2 = WS_X, X_K2 = WS_X + 36 * MiB, X_KTF = WS_X + 72 * MiB, X_KTB = WS_X + 108 * MiB, X_A3 = WS_X + 144 * MiB, X_B3 = WS_X + 252 * MiB,
                 X_KVT = WS_X + 468 * MiB, X_O2 = X_KVT, X_RO = WS_X, X_SG = WS_T;
constexpr size_t X_Q3 = WS_X, X_K3 = WS_X + 36 * MiB, X_VT3 = WS_X + 48 * MiB, X_AO = WS_X + 60 * MiB;
constexpr size_t X_PARTK = WS_X + 160 * MiB;
constexpr size_t WS_END = WS_X + 756 * MiB;

__device__ __forceinline__ unsigned cvt_pk_bf16(float lo, float hi) { unsigned r; asm volatile("v_cvt_pk_bf16_f32 %0, %1, %2" : "=v"(r) : "v"(lo), "v"(hi)); return r; }
__device__ __forceinline__ bf16_t f2bf(float x) { return (bf16_t)(cvt_pk_bf16(x, 0.f) & 0xffffu); }
__device__ __forceinline__ u32x2 pk4(f32x4 v) { u32x2 w; w.x = cvt_pk_bf16(v[0], v[1]); w.y = cvt_pk_bf16(v[2], v[3]); return w; }
__device__ __forceinline__ float bf2f(bf16_t u) { return __uint_as_float(((unsigned)u) << 16); }
__device__ __forceinline__ float ex2(float x) { return __builtin_amdgcn_exp2f(x); }
__device__ __forceinline__ float rcpf(float x) { return __builtin_amdgcn_rcpf(x); }
__device__ __forceinline__ float sigmoidf(float x) { return rcpf(1.f + ex2(-x * LOG2E)); }
__device__ __forceinline__ float siluf(float x) { return x * sigmoidf(x); }
__device__ __forceinline__ float gelu_tanh(float x) { const float z = 0.7978845608028654f * (x + 0.044715f * x * x * x); return x * rcpf(1.f + ex2(-2.f * LOG2E * z)); }
__device__ __forceinline__ int mod_row(int row) { return row < RL ? (row >> 11) : 4; }
__device__ __forceinline__ float wave_sum(float v) {
#pragma unroll
    for (int o = 1; o < 64; o <<= 1) v += __shfl_xor(v, o);
    return v;
}
__device__ __forceinline__ float ret_log2g(int h) {
    const float x = ex2(-5.f - (float)h);
    const float s = x * (1.f + x * (0.5f + x * (1.f / 3.f + x * (0.25f + x * (0.2f + x * (1.f / 6.f + x * (1.f / 7.f)))))));
    return -s * LOG2E;
}

namespace pg8 {
constexpr int BM = 256, BK = 64, HALF = 128, HTB = HALF * BK * 2, STAGE_BYTES = 8 * HTB, NXCD = 8, WGM = 8;
__host__ __device__ __forceinline__ int lds_byte(int r, int c) { const int st = (r >> 4) * 2 + (c >> 5), rr = r & 15, cc = c & 31, ob = rr * 64 + cc * 2; return st * 1024 + (ob ^ (((ob >> 9) & 1) << 5)); }
__host__ __device__ __forceinline__ void stage_rc(int b, int& Rr, int& C) { const int st = b / 1024, sb = b % 1024, swz = sb ^ (((sb >> 9) & 1) << 5); Rr = (st >> 1) * 16 + swz / 64; C = (st & 1) * 32 + (swz % 64) / 2; }

struct Unit { const char* a; const char* b; int pm, pn, nt, aux; };

template <class Map> struct Order {
    int nM, nN, nwg, G, c, nt; Map map;
    __device__ __forceinline__ void init(int nM_, int nN_, int G_, int c_, int K_, const Map& m) { nM = nM_; nN = nN_; nwg = nM_ * nN_; G = G_; c = c_; nt = K_ / BK; map = m; }
    __device__ __forceinline__ bool next(int i, Unit& u) const {
        const long Lx = (long)i * G + c; if (Lx >= nwg) return false;
        int wgid = (int)Lx; { const int q = nwg / NXCD, r = nwg % NXCD, xcd = wgid % NXCD, off = wgid / NXCD; wgid = (xcd < r ? xcd * (q + 1) : r * (q + 1) + (xcd - r) * q) + off; }
        const int nig = WGM * nN, gid = wgid / nig, fm = gid * WGM, gsz = (nM - fm) < WGM ? (nM - fm) : WGM;
        u.pm = fm + ((wgid % nig) % gsz); u.pn = (wgid % nig) / gsz; u.nt = nt; u.aux = 0; map(u); return true;
    }
};

template <class Epi, class Sched, bool ALIGN_EPI>
__device__ __forceinline__ void gemm_phase(LAS unsigned char* lds, const int tid, const int K, const int lda, const int ldb, const Sched& S, const Epi& E) {
    const int wid = __builtin_amdgcn_readfirstlane(tid >> 6), lane = tid & 63, wr = wid >> 2, wc = wid & 3, fr = lane & 15, fq = lane >> 4;
    unsigned voffA[2], voffB[2];
#pragma unroll
    for (int i = 0; i < 2; ++i) { int Rr, C; stage_rc(tid * 16 + i * 8192, Rr, C); voffA[i] = (unsigned)(Rr * lda + C) * 2u; voffB[i] = (unsigned)(Rr * ldb + C) * 2u; }
    const size_t kstep = (size_t)(BK * 2);
    const size_t hstepA = (size_t)HALF * lda * 2, hstepB = (size_t)HALF * ldb * 2;
    const unsigned ldsw = (unsigned)wid * 1024u;
    const int aoff = lds_byte(wr * 64 + fr, fq * 8), boff = lds_byte(wc * 32 + fr, fq * 8);
#define PG8_SA(b, h) (((b) * 2 + (h)) * HTB)
#define PG8_SB(b, h) ((4 + (b) * 2 + (h)) * HTB)
#define PG8_STAGE(bufoff, gbase, voff) do { _Pragma("unroll") for (int _i = 0; _i < 2; ++_i) \
        __builtin_amdgcn_global_load_lds((const unsigned*)((const char*)(gbase) + (voff)[_i]), (LAS unsigned*)(lds + (bufoff) + ldsw + _i * 8192), 16, 0, 0); } while (0)
#define PG8_LDA(dst, b, h) do { _Pragma("unroll") for (int m = 0; m < 4; ++m) _Pragma("unroll") for (int k = 0; k < 2; ++k) dst[m][k] = *(const LAS bf16x8*)(lds + PG8_SA(b, h) + aoff + m * 2048 + k * 1024); } while (0)
#define PG8_LDB(dst, b, h) do { _Pragma("unroll") for (int n = 0; n < 2; ++n) _Pragma("unroll") for (int k = 0; k < 2; ++k) dst[n][k] = *(const LAS bf16x8*)(lds + PG8_SB(b, h) + boff + n * 2048 + k * 1024); } while (0)
#define PG8_MMA(ai, bj, At, Bt) do { __builtin_amdgcn_s_setprio(1); _Pragma("unroll") for (int m = 0; m < 4; ++m) _Pragma("unroll") for (int n = 0; n < 2; ++n) _Pragma("unroll") for (int k = 0; k < 2; ++k) \
        acc[ai][bj][m][n] = __builtin_amdgcn_mfma_f32_16x16x32_bf16(Bt[n][k], At[m][k], acc[ai][bj][m][n], 0, 0, 0); __builtin_amdgcn_s_setprio(0); } while (0)
#define PG8_WAIT_V(n) asm volatile("s_waitcnt vmcnt(" #n ")" ::: "memory")
#define PG8_WAIT_L(n) asm volatile("s_waitcnt lgkmcnt(" #n ")" ::: "memory")
#define PG8_BAR __builtin_amdgcn_s_barrier()
#define PG8_SCHED __builtin_amdgcn_sched_barrier(0)
    Unit cur, nxt; int ui = 0;
    if (!S.next(0, cur)) return;
    f32x4 acc[2][2][4][2];
#pragma unroll
    for (int a = 0; a < 2; ++a)
#pragma unroll
        for (int b = 0; b < 2; ++b)
#pragma unroll
            for (int m = 0; m < 4; ++m)
#pragma unroll
                for (int n = 0; n < 2; ++n) acc[a][b][m][n] = (f32x4){0.f, 0.f, 0.f, 0.f};
    bf16x8 At[4][2], B0[2][2], B1[2][2];
    const char* cA = cur.a; const char* cB = cur.b;
    PG8_STAGE(PG8_SB(0, 0), cB, voffB); PG8_STAGE(PG8_SB(0, 1), cB + hstepB, voffB); PG8_STAGE(PG8_SA(0, 0), cA, voffA); PG8_STAGE(PG8_SA(0, 1), cA + hstepA, voffA);
    if (wr == 1) PG8_BAR;
    PG8_WAIT_V(2); PG8_BAR;
    PG8_STAGE(PG8_SB(1, 0), cB + kstep, voffB); PG8_STAGE(PG8_SA(1, 0), cA + kstep, voffA); PG8_STAGE(PG8_SB(1, 1), cB + hstepB + kstep, voffB);
    PG8_WAIT_V(6); PG8_BAR;
#pragma unroll 1
    for (;;) {
        const bool has_next = S.next(ui + 1, nxt);
        const char* nA = has_next ? nxt.a : cA; const char* nB = has_next ? nxt.b : cB; const int nt = cur.nt;
#pragma unroll 1
        for (int t = 0; t < nt; t += 2) {
            const bool last = (t == nt - 2);
            const char* a1 = cA + (size_t)(t + 1) * kstep;
            const char* a2 = last ? nA : cA + (size_t)(t + 2) * kstep; const char* b2 = last ? nB : cB + (size_t)(t + 2) * kstep;
            const char* a3 = a2 + kstep; const char* b3 = b2 + kstep;
            PG8_LDB(B0, 0, 0); PG8_LDB(B1, 0, 1); PG8_SCHED; PG8_LDA(At, 0, 0); PG8_STAGE(PG8_SA(1, 1), a1 + hstepA, voffA);
            PG8_WAIT_V(8); PG8_WAIT_L(0); PG8_BAR; PG8_MMA(0, 0, At, B0); PG8_MMA(0, 1, At, B1); PG8_BAR; PG8_SCHED;
            PG8_LDA(At, 0, 1); PG8_STAGE(PG8_SB(0, 0), b2, voffB); PG8_STAGE(PG8_SB(0, 1), b2 + hstepB, voffB); PG8_STAGE(PG8_SA(0, 0), a2, voffA);
            PG8_WAIT_V(8); PG8_WAIT_L(0); PG8_BAR; PG8_MMA(1, 0, At, B0); PG8_MMA(1, 1, At, B1); PG8_BAR; PG8_SCHED;
            PG8_LDB(B0, 1, 0); PG8_LDB(B1, 1, 1); PG8_SCHED; PG8_LDA(At, 1, 0); PG8_STAGE(PG8_SA(0, 1), a2 + hstepA, voffA);
            PG8_WAIT_V(8); PG8_WAIT_L(0); PG8_BAR; PG8_MMA(0, 0, At, B0); PG8_MMA(0, 1, At, B1); PG8_BAR; PG8_SCHED;
            PG8_LDA(At, 1, 1); PG8_STAGE(PG8_SB(1, 0), b3, voffB); PG8_STAGE(PG8_SB(1, 1), b3 + hstepB, voffB); PG8_STAGE(PG8_SA(1, 0), a3, voffA);
            PG8_WAIT_V(8); PG8_WAIT_L(0); PG8_BAR; PG8_MMA(1, 0, At, B0); PG8_MMA(1, 1, At, B1); PG8_BAR; PG8_SCHED;
        }
        if constexpr (ALIGN_EPI) { if (wr == 0) PG8_BAR; }
        { int efr = fr, efq = fq, ewr = wr, ewc = wc; asm volatile("" : "+v"(efr), "+v"(efq), "+s"(ewr), "+s"(ewc));
          E(acc, cur, ewr, ewc, efr, efq); }
        if (!has_next) break;
#pragma unroll
        for (int a = 0; a < 2; ++a)
#pragma unroll
            for (int b = 0; b < 2; ++b)
#pragma unroll
                for (int m = 0; m < 4; ++m)
#pragma unroll
                    for (int n = 0; n < 2; ++n) acc[a][b][m][n] = (f32x4){0.f, 0.f, 0.f, 0.f};
        cur = nxt; cA = nA; cB = nB; ++ui;
        if constexpr (ALIGN_EPI) { if (wr == 1) PG8_BAR; }
    }
    PG8_WAIT_V(0);
    if constexpr (!ALIGN_EPI) { if (wr == 0) PG8_BAR; }
    PG8_BAR;
#undef PG8_SA
#undef PG8_SB
#undef PG8_STAGE
#undef PG8_LDA
#undef PG8_LDB
#undef PG8_MMA
#undef PG8_WAIT_V
#undef PG8_WAIT_L
#undef PG8_BAR
#undef PG8_SCHED
}
}
using pg8::Unit;
typedef f32x4 Acc[2][2][4][2];
#define EPI_ROWS(ai, m) _Pragma("unroll") for (int ai = 0; ai < 2; ++ai) _Pragma("unroll") for (int m = 0; m < 4; ++m)
#define EPI_COLS(bj, n) _Pragma("unroll") for (int bj = 0; bj < 2; ++bj) _Pragma("unroll") for (int n = 0; n < 2; ++n)

struct MapPlain { const char* A; const char* B; size_t astep, bstep;
    __device__ __forceinline__ void operator()(Unit& u) const { u.a = A + (size_t)u.pm * astep; u.b = B + (size_t)u.pn * bstep; } };
struct MapLruGate { const char* XC; const char* WG;
    __device__ __forceinline__ void operator()(Unit& u) const { const int blk = (u.pn >> 1) & 7; u.a = XC + ((size_t)u.pm * 256 * D + blk * 256) * 2; u.b = WG + (size_t)u.pn * 256 * 256 * 2; } };
struct MapRetS { const char* Q; const char* Kk;
    __device__ __forceinline__ void operator()(Unit& u) const { const size_t o = ((size_t)u.pm * 256 * D + u.pn * 256) * 2; u.a = Q + o; u.b = Kk + o; } };
struct MapRetKV { const char* B3; const char* KTf; const char* KTb;
    __device__ __forceinline__ void operator()(Unit& u) const { const int half = u.pn & 1, dir = (u.pn >> 1) & 1, h = u.pn >> 2; const size_t ph = (size_t)u.pm * 8 + h;
        u.a = B3 + ((ph * 512 + half * 256) * 768 + 512) * 2; u.b = (dir ? KTb : KTf) + ph * 256 * 256 * 2; } };
struct MapRetOut { const char* A3; const char* B3;
    __device__ __forceinline__ void operator()(Unit& u) const { const int half = u.pn & 1, h = u.pn >> 1; const size_t ph = (size_t)u.pm * 8 + h;
        u.a = A3 + ((size_t)u.pm * 256 * 8 + h) * 768 * 2; u.b = B3 + (ph * 512 + half * 256) * 768 * 2; } };

struct OrderResid {
    const char* A; const char* W; int K, nfullM, nsplitM, G, c;
    __device__ __forceinline__ bool next(int i, Unit& u) const {
        const int L = i * G + c, nfull = nfullM * 8;
        if (L < nfull) { int wgid = L; { const int q = nfull / 8, xcd = wgid % 8, off = wgid / 8; wgid = xcd * q + off; }
            const int nig = 8 * 8, gid = wgid / nig, fm = gid * 8; u.pm = fm + ((wgid % nig) % 8); u.pn = (wgid % nig) / 8; u.nt = K / 64; u.aux = 0;
            u.a = A + (size_t)u.pm * 256 * K * 2; u.b = W + (size_t)u.pn * 256 * K * 2; return true; }
        const int s = L - nfull; if (s >= nsplitM * 64) return false;
        const int xcd = s & 7, j = s >> 3, combo = (xcd * nsplitM * 8) / 8 + (j >> 3), pn = j & 7, cp = combo >> 3, ks = combo & 7;
        u.pm = nfullM + cp; u.pn = pn; u.nt = K / 512; u.aux = 1 + ks;
        u.a = A + ((size_t)u.pm * 256 * K + ks * (K / 8)) * 2; u.b = W + ((size_t)pn * 256 * K + ks * (K / 8)) * 2; return true;
    }
};
struct EpiResid {
    const float* H; float* T; const float* gate; float* PARTK;
    __device__ __forceinline__ void operator()(const Acc& acc, const Unit& u, int wr, int wc, int fr, int fq) const {
        if (u.aux == 0) {
            EPI_ROWS(ai, m) { const int row = u.pm * 256 + ai * 128 + wr * 64 + m * 16 + fr; const float* gp = gate + (size_t)mod_row(row) * MODW;
                EPI_COLS(bj, n) { const int col = u.pn * 256 + bj * 128 + wc * 32 + n * 16 + fq * 4; const size_t o = (size_t)row * D + col;
                    const f32x4 h = *(const f32x4*)(H + o), g = *(const f32x4*)(gp + col); *(f32x4*)(T + o) = h * ALPHA + g * acc[ai][bj][m][n]; }
                asm volatile("" ::: "memory"); }
        } else {
            float* pb = PARTK + (size_t)(u.aux - 1) * RC * D;
            EPI_ROWS(ai, m) { const int row = u.pm * 256 + ai * 128 + wr * 64 + m * 16 + fr - RL;
                EPI_COLS(bj, n) { const int col = u.pn * 256 + bj * 128 + wc * 32 + n * 16 + fq * 4; *(f32x4*)(pb + (size_t)row * D + col) = acc[ai][bj][m][n]; } }
        }
    }
};
struct EpiMlpUp {
    bf16_t* O;
    __device__ __forceinline__ void operator()(const Acc& acc, const Unit& u, int wr, int wc, int fr, int fq) const {
        EPI_ROWS(ai, m) { const int row = u.pm * 256 + ai * 128 + wr * 64 + m * 16 + fr;
            EPI_COLS(bj, n) { const int col = u.pn * 256 + bj * 128 + wc * 32 + n * 16 + fq * 4; f32x4 v = acc[ai][bj][m][n];
#pragma unroll
                for (int j = 0; j < 4; ++j) { const float r = fmaxf(v[j], 0.f); v[j] = r * r; }
                *(u32x2*)(O + (size_t)row * FF + col) = pk4(v); } }
    }
};
struct EpiLruIn {
    bf16_t* GG; float* REC;
    __device__ __forceinline__ void operator()(const Acc& acc, const Unit& u, int wr, int wc, int fr, int fq) const {
        const bool isg = u.pn < 8;
        EPI_ROWS(ai, m) { const int row = u.pm * 256 + ai * 128 + wr * 64 + m * 16 + fr;
            EPI_COLS(bj, n) { const int col = (u.pn & 7) * 256 + bj * 128 + wc * 32 + n * 16 + fq * 4; f32x4 v = acc[ai][bj][m][n];
                if (isg) {
#pragma unroll
                    for (int j = 0; j < 4; ++j) v[j] = gelu_tanh(v[j]);
                    *(u32x2*)(GG + (size_t)row * D + col) = pk4(v);
                } else *(f32x4*)(REC + (size_t)row * D + col) = v; } }
    }
};
struct EpiLruGate {
    const float* XCF; const float* gb; const float* SP; float* AB; float* BB;
    __device__ __forceinline__ void operator()(const Acc& acc, const Unit& u, int wr, int wc, int fr, int fq) const {
        const int half = u.pn & 1, blk = (u.pn >> 1) & 7, dir = u.pn >> 4;
        EPI_ROWS(ai, m) { const int row = u.pm * 256 + ai * 128 + wr * 64 + m * 16 + fr;
#pragma unroll
            for (int n = 0; n < 2; ++n) { const int ch = blk * 256 + half * 128 + wc * 32 + n * 16 + fq * 4;
                const f32x4 br = *(const f32x4*)(gb + (dir * 2 + 0) * D + ch), bi = *(const f32x4*)(gb + (dir * 2 + 1) * D + ch), sp = *(const f32x4*)(SP + dir * D + ch);
                const f32x4 xc = *(const f32x4*)(XCF + (size_t)row * D + ch); const f32x4 rp = acc[ai][0][m][n] + br, ip = acc[ai][1][m][n] + bi; f32x4 av, bv;
#pragma unroll
                for (int j = 0; j < 4; ++j) { const float r = sigmoidf(rp[j]), ig = sigmoidf(ip[j]); const float la = sp[j] * r; const float a = ex2(la * LOG2E); const float y = 2.f * la;
                    const float om_p = -(y * (1.f + y * (0.5f + y * (1.f / 6.f + y * (1.f / 24.f + y * (1.f / 120.f)))))), om_e = 1.f - ex2(y * LOG2E); const float om = (y > -0.1f) ? om_p : om_e;
                    av[j] = a; bv[j] = sqrtf(fmaxf(om, 0.f)) * ig * xc[j]; }
                const size_t o = ((size_t)dir * R + row) * D + ch; *(f32x4*)(AB + o) = av; *(f32x4*)(BB + o) = bv; }
            asm volatile("" ::: "memory"); }
    }
};
struct EpiQKV {
    bf16_t* Q; bf16_t* K; bf16_t* VT; int kcols, vshift, vheads;
    __device__ __forceinline__ void operator()(const Acc& acc, const Unit& u, int wr, int wc, int fr, int fq) const {
        const int col0 = u.pn * 256; const int type = col0 < D ? 0 : (col0 < D + kcols ? 1 : 2);
        if (type < 2) {
            float revf[4];
#pragma unroll
            for (int j = 0; j < 4; ++j) revf[j] = ex2(-(float)(fq * 4 + j) * (13.287712379549449f / 16.f)) * 0.15915494309189535f;
            const float qs = type == 0 ? 0.125f * LOG2E : 1.f;
            EPI_ROWS(ai, m) { const int row = u.pm * 256 + ai * 128 + wr * 64 + m * 16 + fr; const bool lat = row < RL; const int t = row & (SEQ - 1);
                const float pos = (wc & 1) ? (float)(t & 63) : (float)(t >> 6);
                float cs[4], sn[4];
#pragma unroll
                for (int j = 0; j < 4; ++j) { const float rv = pos * revf[j]; cs[j] = lat ? __builtin_amdgcn_cosf(rv) : 1.f; sn[j] = lat ? __builtin_amdgcn_sinf(rv) : 0.f; }
#pragma unroll
                for (int bj = 0; bj < 2; ++bj) { const f32x4 x0 = acc[ai][bj][m][0], x1 = acc[ai][bj][m][1]; f32x4 y0, y1;
#pragma unroll
                    for (int j = 0; j < 4; ++j) { y0[j] = (x0[j] * cs[j] - x1[j] * sn[j]) * qs; y1[j] = (x1[j] * cs[j] + x0[j] * sn[j]) * qs; }
                    const int col = col0 + bj * 128 + wc * 32 + fq * 4;
                    if (type == 0) { bf16_t* p = Q + (size_t)row * D + col; *(u32x2*)p = pk4(y0); *(u32x2*)(p + 16) = pk4(y1); }
                    else { bf16_t* p = K + (size_t)row * kcols + (col - D); *(u32x2*)p = pk4(y0); *(u32x2*)(p + 16) = pk4(y1); } } }
        } else {
            EPI_ROWS(ai, m) { const int row = u.pm * 256 + ai * 128 + wr * 64 + m * 16 + fr; const bool lat = row < RL;
                const int b = lat ? (row >> 11) : ((row - RL) >> 8), tk = lat ? (row & (SEQ - 1)) : (SEQ + ((row - RL) & (CTX - 1)));
                EPI_COLS(bj, n) { const int vc = col0 - D - kcols + bj * 128 + wc * 32 + n * 16 + fq * 4; const int hh = vc >> vshift, e = vc & ((1 << vshift) - 1);
                    bf16_t* p = VT + ((size_t)(b * vheads + hh) * (1 << vshift) + e) * NTOK + tk; const f32x4 v = acc[ai][bj][m][n];
#pragma unroll
                    for (int j = 0; j < 4; ++j) p[(size_t)j * NTOK] = f2bf(v[j]); } }
        }
    }
};
struct EpiRetQKVG {
    bf16_t* Q2; bf16_t* K2; bf16_t* KTf; bf16_t* KTb; bf16_t* A3; bf16_t* B3; bf16_t* SG;
    __device__ __forceinline__ void operator()(const Acc& acc, const Unit& u, int wr, int wc, int fr, int fq) const {
        const int pn = u.pn;
        if (pn < 8) { const int h = pn; const float lgf = ret_log2g(h), lgb = ret_log2g(7 - h);
            EPI_ROWS(ai, m) { const int pos = ai * 128 + wr * 64 + m * 16 + fr; const int row = u.pm * 256 + pos; const float df = ex2((float)(pos + 1) * lgf), db = ex2((float)(256 - pos) * lgb);
                EPI_COLS(bj, n) { const int d = bj * 128 + wc * 32 + n * 16 + fq * 4; const f32x4 q = acc[ai][bj][m][n] * 0.0625f;
                    *(u32x2*)(Q2 + (size_t)row * D + h * 256 + d) = pk4(q); bf16_t* ap = A3 + ((size_t)row * 8 + h) * 768 + d;
                    *(u32x2*)ap = pk4(q * df); *(u32x2*)(ap + 256) = pk4(q * db); } }
        } else if (pn < 16) { const int h = pn - 8; const float lgf = ret_log2g(h), lgb = ret_log2g(7 - h);
            EPI_ROWS(ai, m) { const int pos = ai * 128 + wr * 64 + m * 16 + fr; const int row = u.pm * 256 + pos; const float df = ex2((float)(255 - pos) * lgf), db = ex2((float)pos * lgb);
                EPI_COLS(bj, n) { const int d = bj * 128 + wc * 32 + n * 16 + fq * 4; const f32x4 k = acc[ai][bj][m][n];
                    *(u32x2*)(K2 + (size_t)row * D + h * 256 + d) = pk4(k); const size_t to = (((size_t)u.pm * 8 + h) * 256 + d) * 256 + pos;
#pragma unroll
                    for (int j = 0; j < 4; ++j) { KTf[to + j * 256] = f2bf(k[j] * df); KTb[to + j * 256] = f2bf(k[j] * db); } } }
        } else if (pn < 32) { const int h = (pn - 16) >> 1, half = (pn - 16) & 1;
            EPI_ROWS(ai, m) { const int pos = ai * 128 + wr * 64 + m * 16 + fr;
                EPI_COLS(bj, n) { const int e = half * 256 + bj * 128 + wc * 32 + n * 16 + fq * 4; const f32x4 v = acc[ai][bj][m][n];
                    bf16_t* p = B3 + (((size_t)u.pm * 8 + h) * 512 + e) * 768 + 512 + pos;
#pragma unroll
                    for (int j = 0; j < 4; ++j) p[j * 768] = f2bf(v[j]); } }
        } else {
            EPI_ROWS(ai, m) { const int row = u.pm * 256 + ai * 128 + wr * 64 + m * 16 + fr;
                EPI_COLS(bj, n) { const int col = (pn - 32) * 256 + bj * 128 + wc * 32 + n * 16 + fq * 4; f32x4 v = acc[ai][bj][m][n];
#pragma unroll
                    for (int j = 0; j < 4; ++j) v[j] = siluf(v[j]);
                    *(u32x2*)(SG + (size_t)row * 4096 + col) = pk4(v); } }
        }
    }
};
struct EpiRetS {
    bf16_t* A3;
    __device__ __forceinline__ void operator()(const Acc& acc, const Unit& u, int wr, int wc, int fr, int fq) const {
        const int h = u.pn; const float lgf = ret_log2g(h), lgb = ret_log2g(7 - h);
        EPI_ROWS(ai, m) { const int i = ai * 128 + wr * 64 + m * 16 + fr; const int row = u.pm * 256 + i;
            EPI_COLS(bj, n) { const int j0 = bj * 128 + wc * 32 + n * 16 + fq * 4; f32x4 v = acc[ai][bj][m][n];
#pragma unroll
                for (int j = 0; j < 4; ++j) { const int rel = i - (j0 + j); v[j] *= rel >= 0 ? ex2((float)rel * lgf) : ex2((float)(-rel) * lgb); }
                *(u32x2*)(A3 + ((size_t)row * 8 + h) * 768 + 512 + j0) = pk4(v); } }
    }
};
struct EpiRetKV {
    float* KVT;
    __device__ __forceinline__ void operator()(const Acc& acc, const Unit& u, int wr, int wc, int fr, int fq) const {
        const int half = u.pn & 1, hd = u.pn >> 1;
        float* base = KVT + (((size_t)u.pm * 16 + hd) * 512 + half * 256) * 256;
        EPI_ROWS(ai, m) { const int r = ai * 128 + wr * 64 + m * 16 + fr;
            EPI_COLS(bj, n) { const int c = bj * 128 + wc * 32 + n * 16 + fq * 4; *(f32x4*)(base + (size_t)r * 256 + c) = acc[ai][bj][m][n]; } }
    }
};
struct EpiRetOut {
    float* O2;
    __device__ __forceinline__ void operator()(const Acc& acc, const Unit& u, int wr, int wc, int fr, int fq) const {
        EPI_ROWS(ai, m) { const int row = u.pm * 256 + ai * 128 + wr * 64 + m * 16 + fr;
            EPI_COLS(bj, n) { const int c = u.pn * 256 + bj * 128 + wc * 32 + n * 16 + fq * 4; *(f32x4*)(O2 + (size_t)row * 4096 + c) = acc[ai][bj][m][n]; } }
    }
};

template <int DV, bool OUTBF>
__device__ __forceinline__ void attn_unit(LAS unsigned char* lds, const int tid, const bf16_t* q, int ldq, const bf16_t* k0, const bf16_t* k1, int ldk,
                                          const bf16_t* vt0, const bf16_t* vt1, int ldvt, int nt0, int nt1, bool band, int qpos0, int kpos0,
                                          bool has_sink, float sink_l2, void* o, int ldo) {
    constexpr int KT_BYTES = 64 * 144, VT_BYTES = DV * 136, BUF = KT_BYTES + VT_BYTES, NV = DV / 64, NDV = DV / 32;
    const int lane = tid & 63, w = tid >> 6, c32 = lane & 31, hi = lane >> 5, srow = tid >> 3, sch = tid & 7;
    bf16x8 qf[4];
#pragma unroll
    for (int ks = 0; ks < 4; ++ks) qf[ks] = *(const bf16x8*)(q + (size_t)(32 * w + c32) * ldq + ks * 16 + hi * 8);
    f32x16 oacc[NDV];
#pragma unroll
    for (int i = 0; i < NDV; ++i)
#pragma unroll
        for (int r = 0; r < 16; ++r) oacc[i][r] = 0.f;
    float m_run = -1e30f, l_run = 0.f;
    const int ntile = nt0 + nt1;
    u32x4 kreg, vreg[NV];
    { const bf16_t* kp = nt0 > 0 ? k0 : k1; const bf16_t* vp = nt0 > 0 ? vt0 : vt1;
      kreg = *(const u32x4*)(kp + (size_t)srow * ldk + sch * 8);
#pragma unroll
      for (int i = 0; i < NV; ++i) vreg[i] = *(const u32x4*)(vp + (size_t)(srow + 64 * i) * ldvt + sch * 8); }
#pragma unroll 1
    for (int t = 0; t < ntile; ++t) {
        LAS unsigned char* kb = lds + (t & 1) * BUF; LAS unsigned char* vb = kb + KT_BYTES;
        *(LAS u32x4*)(kb + srow * 144 + sch * 16) = kreg;
#pragma unroll
        for (int i = 0; i < NV; ++i) { LAS unsigned char* p = vb + (srow + 64 * i) * 136 + sch * 16; *(LAS u32x2*)p = (u32x2){vreg[i].x, vreg[i].y}; *(LAS u32x2*)(p + 8) = (u32x2){vreg[i].z, vreg[i].w}; }
        __syncthreads();
        if (t + 1 < ntile) { const int t1 = t + 1; const bf16_t* kp = t1 < nt0 ? k0 + (size_t)(t1 * 64) * ldk : k1 + (size_t)((t1 - nt0) * 64) * ldk;
            const bf16_t* vp = t1 < nt0 ? vt0 + t1 * 64 : vt1 + (t1 - nt0) * 64;
            kreg = *(const u32x4*)(kp + (size_t)srow * ldk + sch * 8);
#pragma unroll
            for (int i = 0; i < NV; ++i) vreg[i] = *(const u32x4*)(vp + (size_t)(srow + 64 * i) * ldvt + sch * 8); }
        f32x16 sacc[2];
#pragma unroll
        for (int a = 0; a < 2; ++a) {
#pragma unroll
            for (int r = 0; r < 16; ++r) sacc[a][r] = 0.f;
#pragma unroll
            for (int ks = 0; ks < 4; ++ks) { const bf16x8 kf = *(const LAS bf16x8*)(kb + (32 * a + c32) * 144 + ks * 32 + hi * 16); sacc[a] = __builtin_amdgcn_mfma_f32_32x32x16_bf16(kf, qf[ks], sacc[a], 0, 0, 0); }
        }
        if (band && t < nt0) { const int qp = qpos0 + 32 * w + c32;
#pragma unroll
            for (int a = 0; a < 2; ++a)
#pragma unroll
                for (int r = 0; r < 16; ++r) { const int kp = kpos0 + t * 64 + 32 * a + (r & 3) + 8 * (r >> 2) + 4 * hi; const int dlt = kp - qp; if (dlt > 128 || dlt < -128) sacc[a][r] = -INFINITY; } }
        float mx = -INFINITY;
#pragma unroll
        for (int a = 0; a < 2; ++a)
#pragma unroll
            for (int r = 0; r < 16; ++r) mx = fmaxf(mx, sacc[a][r]);
        mx = fmaxf(mx, __shfl_xor(mx, 32));
        const float mnew = fmaxf(m_run, mx), alpha = ex2(m_run - mnew); m_run = mnew;
        float ls = 0.f;
#pragma unroll
        for (int a = 0; a < 2; ++a)
#pragma unroll
            for (int r = 0; r < 16; ++r) { const float p = ex2(sacc[a][r] - mnew); sacc[a][r] = p; ls += p; }
        l_run = l_run * alpha + ls;
#pragma unroll
        for (int i = 0; i < NDV; ++i)
#pragma unroll
            for (int r = 0; r < 16; ++r) oacc[i][r] *= alpha;
        bf16x8 pf[4];
#pragma unroll
        for (int a = 0; a < 2; ++a)
#pragma unroll
            for (int jj = 0; jj < 2; ++jj) { u32x4 wv; wv.x = cvt_pk_bf16(sacc[a][8 * jj + 0], sacc[a][8 * jj + 1]); wv.y = cvt_pk_bf16(sacc[a][8 * jj + 2], sacc[a][8 * jj + 3]);
                wv.z = cvt_pk_bf16(sacc[a][8 * jj + 4], sacc[a][8 * jj + 5]); wv.w = cvt_pk_bf16(sacc[a][8 * jj + 6], sacc[a][8 * jj + 7]); pf[2 * a + jj] = __builtin_bit_cast(bf16x8, wv); }
#pragma unroll
        for (int i = 0; i < NDV; ++i)
#pragma unroll
            for (int j = 0; j < 4; ++j) { const LAS unsigned char* p = vb + (32 * i + c32) * 136 + (16 * j + 4 * hi) * 2; const u32x2 lo = *(const LAS u32x2*)p, hh = *(const LAS u32x2*)(p + 16);
                const u32x4 wv = (u32x4){lo.x, lo.y, hh.x, hh.y}; oacc[i] = __builtin_amdgcn_mfma_f32_32x32x16_bf16(__builtin_bit_cast(bf16x8, wv), pf[j], oacc[i], 0, 0, 0); }
    }
    float lt = l_run + __shfl_xor(l_run, 32);
    if (has_sink) lt += ex2(sink_l2 - m_run);
    const float inv = 1.f / lt;
    const int row = 32 * w + c32;
#pragma unroll
    for (int i = 0; i < NDV; ++i)
#pragma unroll
        for (int g = 0; g < 4; ++g) { const int col = 32 * i + 8 * g + 4 * hi; const f32x4 v = (f32x4){oacc[i][4 * g], oacc[i][4 * g + 1], oacc[i][4 * g + 2], oacc[i][4 * g + 3]} * inv;
            if (OUTBF) *(u32x2*)((bf16_t*)o + (size_t)row * ldo + col) = pk4(v); else *(f32x4*)((float*)o + (size_t)row * ldo + col) = v; }
    __syncthreads();
}

#define XB_TMO      128
#define XB_XCNT(j)  (256  + 64 * (j))
#define XB_XSUB(j)  (1280 + 64 * (j))
#define XB_XGEN(j)  (2304 + 64 * (j))
#define XB_TOP      3328
#define XB_TOPGEN   3392
#define XCD_BAR_WORDS 3456
#define XB_SPIN_CAP (1u << 18)
__device__ __forceinline__ unsigned xb_ld(unsigned* p)              { return __hip_atomic_load(p, __ATOMIC_RELAXED, __HIP_MEMORY_SCOPE_AGENT); }
__device__ __forceinline__ unsigned xb_add(unsigned* p, unsigned v) { return __hip_atomic_fetch_add(p, v, __ATOMIC_RELAXED, __HIP_MEMORY_SCOPE_AGENT); }
__device__ __forceinline__ unsigned xb_xcc_id() { return (unsigned)__builtin_amdgcn_s_getreg((3 << 11) | 20) & 0xFu; }
#define XB_SPIN(cond, bar) do { unsigned _sp = 0; while (cond) { __builtin_amdgcn_s_sleep(1); \
    if ((++_sp & 255u) == 0u) { if (xb_ld(&(bar)[XB_TMO])) break; if (_sp > XB_SPIN_CAP) { atomicAdd(&(bar)[XB_TMO], 1u); break; } } } } while (0)
struct XcdBarrier { unsigned* bar; unsigned x; volatile LAS unsigned* st; };
__device__ __forceinline__ XcdBarrier xcd_barrier_post(unsigned* bar, volatile LAS unsigned* st) {
    XcdBarrier b; b.bar = bar; b.x = xb_xcc_id(); b.st = st;
    if (threadIdx.x == 0) (void)xb_add(&bar[XB_XCNT(b.x)], 1u);
    return b;
}
__device__ __forceinline__ void xcd_barrier_complete(unsigned* bar, unsigned x, unsigned& nloc, unsigned& nx) {
    const unsigned G = gridDim.x * gridDim.y * gridDim.z;
    unsigned sum, cnt, mine, sp = 0u;
    for (;;) {
        sum = 0u; cnt = 0u; mine = 0u;
#pragma unroll
        for (unsigned j = 0; j < 16; ++j) { const unsigned c = xb_ld(&bar[XB_XCNT(j)]); sum += c; cnt += (c > 0u) ? 1u : 0u; mine = (j == x) ? c : mine; }
        if (sum == G) break;
        __builtin_amdgcn_s_sleep(1);
        if ((++sp & 255u) == 0u) { if (xb_ld(&bar[XB_TMO])) break; if (sp > XB_SPIN_CAP) { atomicAdd(&bar[XB_TMO], 1u); break; } }
    }
    nloc = mine > 0u ? mine : 1u; nx = cnt > 0u ? cnt : 1u;
}
__device__ __forceinline__ void xcd_barrier(const XcdBarrier& b) {
    asm volatile("s_waitcnt vmcnt(0)" ::: "memory");
    __syncthreads();
    if (threadIdx.x == 0) {
        unsigned* bar = b.bar;
        __builtin_amdgcn_s_waitcnt(0);
        unsigned nloc = b.st[0], nx = b.st[1];
        if (nloc == 0u) { xcd_barrier_complete(bar, b.x, nloc, nx); b.st[0] = nloc; b.st[1] = nx; }
        const unsigned old = xb_add(&bar[XB_XSUB(b.x)], 1u);
        const unsigned gen = old / nloc;
        if (old + 1u == (gen + 1u) * nloc) {
            __builtin_amdgcn_fence(__ATOMIC_RELEASE, "agent");
            asm volatile("s_waitcnt vmcnt(0)" ::: "memory");
            const unsigned og = xb_add(&bar[XB_TOP], 1u);
            const unsigned tg = og / nx;
            if (og + 1u == (tg + 1u) * nx) xb_add(&bar[XB_TOPGEN], 1u);
            else XB_SPIN(xb_ld(&bar[XB_TOPGEN]) == tg, bar);
            __builtin_amdgcn_fence(__ATOMIC_ACQUIRE, "agent");
            xb_add(&bar[XB_XGEN(b.x)], 1u);
            asm volatile("s_waitcnt vmcnt(0)" ::: "memory");
        } else {
            XB_SPIN(xb_ld(&bar[XB_XGEN(b.x)]) == gen, bar);
            __builtin_amdgcn_fence(__ATOMIC_ACQUIRE, "agent");
            asm volatile("s_waitcnt vmcnt(0)" ::: "memory");
        }
    }
    __syncthreads();
}

constexpr int NWAVES = 8, NTHR = 512;
constexpr int RING_BYTES = 131072, MISC_OFF = RING_BYTES + 320, LDS_BYTES = 147456;
constexpr int CW_BAR = 4096;
constexpr int NPHASE = 3 + 12 * DEPTH;

struct Args { const float* in[26]; float* out; unsigned char* ws; int ph_lo, ph_hi; };
enum { I_X = 0, I_C, I_CTX, I_CCTX, I_ADAW, I_ADAB, I_LNG, I_LNB, I_W1, I_W2, I_LIN, I_LCW, I_LCB, I_LGW, I_LGB, I_LLAM, I_LOUT, I_DQKV, I_DLAM, I_DSUB, I_DOUT, I_RQKVG, I_ROUT, I_SQKV, I_SSINK, I_SOUT };

__device__ __forceinline__ unsigned pk2(float lo, float hi) { return cvt_pk_bf16(lo, hi); }
__device__ __forceinline__ void tr_item(const float* W, int ldw, bf16_t* WT, int ldt, int k0, int n0, LAS float* scr, int lane) {
#pragma unroll 8
    for (int i = 0; i < 32; ++i) { const int kk = 2 * i + (lane >> 5); scr[kk * 33 + (lane & 31)] = W[(size_t)(k0 + kk) * ldw + n0 + (lane & 31)]; }
    asm volatile("s_waitcnt lgkmcnt(0)" ::: "memory");
    const int c = lane & 7;
#pragma unroll
    for (int j = 0; j < 4; ++j) { const int n = (lane >> 3) + 8 * j; const LAS float* s = scr + (8 * c) * 33 + n;
        u32x4 o; o.x = pk2(s[0 * 33], s[1 * 33]); o.y = pk2(s[2 * 33], s[3 * 33]); o.z = pk2(s[4 * 33], s[5 * 33]); o.w = pk2(s[6 * 33], s[7 * 33]);
        *(u32x4*)(WT + (size_t)(n0 + n) * ldt + k0 + 8 * c) = o; }
    asm volatile("s_waitcnt lgkmcnt(0)" ::: "memory");
}
__device__ __forceinline__ void tr_job(const float* W, int K, int N, bf16_t* WT, LAS float* scr, int lane, int gw, int NGW, int& base) {
    const int nblk = N / 32, nitems = (K / 64) * nblk;
    for (int it = ((gw - base) % NGW + NGW) % NGW; it < nitems; it += NGW) tr_item(W, N, WT, K, 64 * (it / nblk), 32 * (it % nblk), scr, lane);
    base += nitems;
}

__device__ __forceinline__ unsigned char* launder_ptr(unsigned char* p) { unsigned long long w = (unsigned long long)p; unsigned l = (unsigned)w, h = (unsigned)(w >> 32);
    asm volatile("" : "+v"(l), "+v"(h)); l = __builtin_amdgcn_readfirstlane(l); h = __builtin_amdgcn_readfirstlane(h); return (unsigned char*)(((unsigned long long)h << 32) | l); }
__device__ __forceinline__ const float* input_ptr(const Args& a, int k) { asm volatile("" : "+v"(k)); k = __builtin_amdgcn_readfirstlane(k); return a.in[k]; }
#define PHFN __device__ __forceinline__
PHFN void ph_lru_in(LAS unsigned char* lds, const int tid, unsigned char* ws, int G, int bid) {
    pg8::Order<MapPlain> S; S.init(R / 256, 16, G, bid, D, MapPlain{(const char*)(ws + WS_U), (const char*)(ws + W_LRU_IN), (size_t)256 * D * 2, (size_t)256 * D * 2});
    EpiLruIn E{(bf16_t*)(ws + X_GG), (float*)(ws + X_REC)};
    pg8::gemm_phase<EpiLruIn, pg8::Order<MapPlain>, true>(lds, tid, D, D, D, S, E);
}
PHFN void ph_lru_gate(LAS unsigned char* lds, const int tid, unsigned char* ws, const float* gb, int G, int bid) {
    pg8::Order<MapLruGate> S; S.init(R / 256, 32, G, bid, 256, MapLruGate{(const char*)(ws + X_XCB), (const char*)(ws + W_LRU_G)});
    EpiLruGate E{(const float*)(ws + X_XCF), gb, (const float*)(ws + WS_SP), (float*)(ws + X_AB), (float*)(ws + X_BB)};
    pg8::gemm_phase<EpiLruGate, pg8::Order<MapLruGate>, true>(lds, tid, 256, D, 256, S, E);
}
PHFN void ph_qkv(LAS unsigned char* lds, const int tid, unsigned char* ws, int swa, int G, int bid) {
    pg8::Order<MapPlain> S; S.init(R / 256, swa ? 12 : 24, G, bid, D, MapPlain{(const char*)(ws + WS_U), (const char*)(ws + (swa ? W_SWA_QKV : W_DIF_QKV)), (size_t)256 * D * 2, (size_t)256 * D * 2});
    EpiQKV E{(bf16_t*)(ws + X_Q1), (bf16_t*)(ws + X_K1), (bf16_t*)(ws + (swa ? X_VT3 : X_VT1)), swa ? 512 : 2048, swa ? 6 : 7, swa ? 8 : 16};
    pg8::gemm_phase<EpiQKV, pg8::Order<MapPlain>, true>(lds, tid, D, D, D, S, E);
}
PHFN void ph_ret_qkvg(LAS unsigned char* lds, const int tid, unsigned char* ws, int G, int bid) {
    pg8::Order<MapPlain> S; S.init(R / 256, 48, G, bid, D, MapPlain{(const char*)(ws + WS_U), (const char*)(ws + W_RET_QKVG), (size_t)256 * D * 2, (size_t)256 * D * 2});
    EpiRetQKVG E{(bf16_t*)(ws + X_Q2), (bf16_t*)(ws + X_K2), (bf16_t*)(ws + X_KTF), (bf16_t*)(ws + X_KTB), (bf16_t*)(ws + X_A3), (bf16_t*)(ws + X_B3), (bf16_t*)(ws + X_SG)};
    pg8::gemm_phase<EpiRetQKVG, pg8::Order<MapPlain>, true>(lds, tid, D, D, D, S, E);
}
PHFN void ph_ret_s(LAS unsigned char* lds, const int tid, unsigned char* ws, int G, int bid) {
    pg8::Order<MapRetS> S; S.init(R / 256, 8, G, bid, 256, MapRetS{(const char*)(ws + X_Q2), (const char*)(ws + X_K2)});
    EpiRetS E{(bf16_t*)(ws + X_A3)};
    pg8::gemm_phase<EpiRetS, pg8::Order<MapRetS>, true>(lds, tid, 256, D, D, S, E);
}
PHFN void ph_ret_kv(LAS unsigned char* lds, const int tid, unsigned char* ws, int G, int bid) {
    pg8::Order<MapRetKV> S; S.init(R / 256, 32, G, bid, 256, MapRetKV{(const char*)(ws + X_B3), (const char*)(ws + X_KTF), (const char*)(ws + X_KTB)});
    EpiRetKV E{(float*)(ws + X_KVT)};
    pg8::gemm_phase<EpiRetKV, pg8::Order<MapRetKV>, true>(lds, tid, 256, 768, 256, S, E);
}
PHFN void ph_ret_out(LAS unsigned char* lds, const int tid, unsigned char* ws, int G, int bid) {
    pg8::Order<MapRetOut> S; S.init(R / 256, 16, G, bid, 768, MapRetOut{(const char*)(ws + X_A3), (const char*)(ws + X_B3)});
    EpiRetOut E{(float*)(ws + X_O2)};
    pg8::gemm_phase<EpiRetOut, pg8::Order<MapRetOut>, true>(lds, tid, 768, 8 * 768, 768, S, E);
}
template <int K> PHFN void ph_resid(LAS unsigned char* lds, const int tid, unsigned char* ws, const bf16_t* A, const bf16_t* W, int nrows, const float* gate, int G, int bid) {
    OrderResid S{(const char*)A, (const char*)W, K, RL / 256, (nrows - RL) / 256, G, bid};
    EpiResid E{(const float*)(ws + WS_H), (float*)(ws + WS_T), gate, (float*)(ws + X_PARTK)};
    pg8::gemm_phase<EpiResid, OrderResid, true>(lds, tid, K, K, K, S, E);
}
PHFN void ph_up(LAS unsigned char* lds, const int tid, unsigned char* ws, int layer, int nrows, int G, int bid) {
    pg8::Order<MapPlain> S; S.init(nrows / 256, FF / 256, G, bid, D, MapPlain{(const char*)(ws + WS_U), (const char*)(ws + W_MLP1) + (size_t)layer * D * FF * 2, (size_t)256 * D * 2, (size_t)256 * D * 2});
    EpiMlpUp E{(bf16_t*)(ws + X_ACT)};
    pg8::gemm_phase<EpiMlpUp, pg8::Order<MapPlain>, true>(lds, tid, D, D, D, S, E);
}
PHFN void ph_attn_dif(LAS unsigned char* lds, const int tid, unsigned char* ws, int G, int bid) {
    const bf16_t* Q1 = (const bf16_t*)(ws + X_Q1); const bf16_t* K1 = (const bf16_t*)(ws + X_K1); const bf16_t* VT1 = (const bf16_t*)(ws + X_VT1); float* OD = (float*)(ws + X_OD);
#pragma unroll 1
    for (int u = bid; u < 1152; u += G) {
        int b, h, mm, qrow, nt0;
        if (u < 1024) { const int qb = u & 7; mm = (u >> 3) & 1; h = (u >> 4) & 15; b = u >> 8; qrow = b * SEQ + qb * 256; nt0 = 32; }
        else { const int v = u - 1024; mm = v & 1; h = (v >> 1) & 15; b = v >> 5; qrow = RL + b * CTX; nt0 = 0; }
        const int hc = h * 128 + mm * 64;
        const bf16_t* vt = VT1 + ((size_t)(b * 16 + h) * 128) * NTOK;
        attn_unit<128, false>(lds, tid, Q1 + (size_t)qrow * D + hc, D, K1 + (size_t)(b * SEQ) * D + hc, K1 + (size_t)(RL + b * CTX) * D + hc, D,
                              vt, vt + SEQ, NTOK, nt0, 4, false, 0, 0, false, 0.f, OD + (size_t)mm * R * D + (size_t)qrow * D + h * 128, D);
    }
}
PHFN void ph_attn_swa(LAS unsigned char* lds, const int tid, unsigned char* ws, const float* sink, int G, int bid) {
    const bf16_t* Q3 = (const bf16_t*)(ws + X_Q3); const bf16_t* K3 = (const bf16_t*)(ws + X_K3); const bf16_t* VT3 = (const bf16_t*)(ws + X_VT3); bf16_t* AO = (bf16_t*)(ws + X_AO);
#pragma unroll 1
    for (int u = bid; u < 1024; u += G) {
        const int qb = u & 7, hq = (u >> 3) & 31, b = u >> 8, kvh = hq >> 2; const int qrow = b * SEQ + qb * 256;
        const int klo = qb * 256 - 128 < 0 ? 0 : qb * 256 - 128, khi = qb * 256 + 384 > SEQ ? SEQ : qb * 256 + 384;
        const bf16_t* vt = VT3 + ((size_t)(b * 8 + kvh) * 64) * NTOK;
        attn_unit<64, true>(lds, tid, Q3 + (size_t)qrow * D + hq * 64, D, K3 + (size_t)(b * SEQ + klo) * 512 + kvh * 64, K3 + (size_t)(RL + b * CTX) * 512 + kvh * 64, 512,
                            vt + klo, vt + SEQ, NTOK, (khi - klo) / 64, 4, true, qb * 256, klo, true, sink[hq] * LOG2E, AO + (size_t)qrow * D + hq * 64, D);
    }
}


__device__ __forceinline__ int phase_group(int ph) {
    if (ph < 1) return 0; if (ph < 3) return 1;
    const int layer = (ph - 3) / 12, k = (ph - 3) % 12;
    if (k == 7) return 14; if (k == 8 || k == 11) return 15; if (k == 9) return 16; if (k == 10) return 17;
    if (layer == 0) return k == 0 ? 2 : (k == 2 ? 4 : 3);
    if (layer == 1) return 5 + k;
    if (layer == 2) return k == 0 ? 8 : (k <= 2 ? 9 : (k == 4 ? 11 : 10));
    return 12 + k;
}
#ifdef DUP_GROUP
#define REPLOOP(k) _Pragma("unroll 1") for (int rep_ = 0, nrep_ = (phase_group(k) == DUP_GROUP ? 2 : 1); rep_ < nrep_; ++rep_)
#define NBAR (DUP_GROUP == 18 ? 2 : 1)
#else
#define REPLOOP(k)
#define NBAR 1
#endif
__global__ void __launch_bounds__(NTHR, 2) fwd(Args args) {
    extern __shared__ __attribute__((aligned(16))) unsigned char lds_raw[];
    LAS unsigned char* lds = (LAS unsigned char*)lds_raw;
    for (int u = threadIdx.x; u < (LDS_BYTES - RING_BYTES) / 4; u += NTHR) ((LAS unsigned*)(lds + RING_BYTES))[u] = 0u;
    __syncthreads();
    (void)xcd_barrier_post((unsigned*)(args.ws + WS_CTL) + CW_BAR, (volatile LAS unsigned*)(lds + MISC_OFF) + 8);
#ifdef PH_TEST
    const int lo = PH_TEST, hi = PH_TEST + 1;
#else
    const int lo = args.ph_lo, hi = args.ph_hi;
#endif
#define IN(k) (lo <= (k) && (k) < hi)
#define PH_BEGIN() int tid = threadIdx.x, bid = blockIdx.x, G = gridDim.x; unsigned char* ws = launder_ptr(args.ws); \
    asm volatile("" : "+v"(tid), "+v"(bid), "+v"(G)); bid = __builtin_amdgcn_readfirstlane(bid); G = __builtin_amdgcn_readfirstlane(G); \
    const int lane = tid & 63, wave = __builtin_amdgcn_readfirstlane(tid >> 6); \
    const int gw = bid * NWAVES + wave, NGW = G * NWAVES; const size_t gtid = (size_t)bid * NTHR + tid, NGT = (size_t)G * NTHR; \
    (void)lane; (void)wave; (void)gw; (void)NGW; (void)gtid; (void)NGT; \
    float* MOD = (float*)(ws + WS_MOD); float* SP = (float*)(ws + WS_SP); float* PART = (float*)(ws + WS_PART); \
    float* Hs = (float*)(ws + WS_H); float* Ts = (float*)(ws + WS_T); bf16_t* Us = (bf16_t*)(ws + WS_U); \
    (void)MOD; (void)SP; (void)PART; (void)Hs; (void)Ts; (void)Us;
#define INP(k) input_ptr(args, (k))
#define SEAM(k) do { if ((k) + 1 < hi) { unsigned char* wsb = launder_ptr(args.ws); XcdBarrier bar; bar.bar = (unsigned*)(wsb + WS_CTL) + CW_BAR; bar.x = xb_xcc_id(); \
    bar.st = (volatile LAS unsigned*)(lds + MISC_OFF) + 8; for (int nb_ = 0; nb_ < NBAR; ++nb_) xcd_barrier(bar); } } while (0)

    if (IN(0)) { REPLOOP(0) { PH_BEGIN();
        LAS float* sl = (LAS float*)(lds + 81920);
        for (int i = tid; i < 5 * D; i += NTHR) { const int r = i >> 11, k = i & (D - 1); const float v = r < 4 ? INP(I_C)[r * D + k] : INP(I_CCTX)[k]; sl[i] = siluf(v); }
        __syncthreads();
        for (int task = gw; task < 4 * 8 * 48; task += NGW) {
            const int cc = task % 48, ks = (task / 48) & 7, l = task / 384; const int n0 = cc * 256 + lane * 4;
            const float* wp = INP(I_ADAW) + ((size_t)l * D + ks * 256) * MODW + n0;
            f32x4 a0 = {0, 0, 0, 0}, a1 = a0, a2 = a0, a3 = a0, a4 = a0;
#pragma unroll 8
            for (int k = 0; k < 256; ++k) { const f32x4 wv = *(const f32x4*)(wp + (size_t)k * MODW); const int kk = ks * 256 + k;
                a0 += wv * sl[kk]; a1 += wv * sl[D + kk]; a2 += wv * sl[2 * D + kk]; a3 += wv * sl[3 * D + kk]; a4 += wv * sl[4 * D + kk]; }
            float* pp = PART + ((size_t)(ks * 4 + l) * 5) * MODW + n0;
            *(f32x4*)(pp) = a0; *(f32x4*)(pp + MODW) = a1; *(f32x4*)(pp + 2 * MODW) = a2; *(f32x4*)(pp + 3 * MODW) = a3; *(f32x4*)(pp + 4 * MODW) = a4;
        }
        LAS float* scr = (LAS float*)(lds + wave * 8448);
        int base = 0;
        tr_job(INP(I_LIN), D, 4096, (bf16_t*)(ws + W_LRU_IN), scr, lane, gw, NGW, base);
        {
            const int nitems = 64 * 16;
            for (int it = ((gw - base) % NGW + NGW) % NGW; it < nitems; it += NGW) { const int sb = it >> 4, kb = (it >> 2) & 3, nb = it & 3;
                const int half = sb & 1, blk = (sb >> 1) & 7, g = (sb >> 4) & 1, dir = sb >> 5;
                const float* src = INP(I_LGW) + (size_t)(((dir * 2 + g) * 8 + blk)) * 65536 + half * 128;
                bf16_t* dst = (bf16_t*)(ws + W_LRU_G) + ((size_t)(((dir * 8 + blk) * 2 + half) * 256 + g * 128)) * 256;
                tr_item(src, 256, dst, 256, 64 * kb, 32 * nb, scr, lane); }
            base += nitems;
        }
        tr_job(INP(I_LOUT), D, D, (bf16_t*)(ws + W_LRU_OUT), scr, lane, gw, NGW, base);
        tr_job(INP(I_DQKV), D, 6144, (bf16_t*)(ws + W_DIF_QKV), scr, lane, gw, NGW, base);
        tr_job(INP(I_DOUT), D, D, (bf16_t*)(ws + W_DIF_OUT), scr, lane, gw, NGW, base);
        tr_job(INP(I_RQKVG), D, 12288, (bf16_t*)(ws + W_RET_QKVG), scr, lane, gw, NGW, base);
        tr_job(INP(I_ROUT), 4096, D, (bf16_t*)(ws + W_RET_OUT), scr, lane, gw, NGW, base);
        tr_job(INP(I_SQKV), D, 3072, (bf16_t*)(ws + W_SWA_QKV), scr, lane, gw, NGW, base);
        tr_job(INP(I_SOUT), D, D, (bf16_t*)(ws + W_SWA_OUT), scr, lane, gw, NGW, base);
#pragma unroll 1
        for (int l = 0; l < DEPTH; ++l) {
            tr_job(INP(I_W1) + (size_t)l * D * FF, D, FF, (bf16_t*)(ws + W_MLP1) + (size_t)l * D * FF, scr, lane, gw, NGW, base);
            tr_job(INP(I_W2) + (size_t)l * D * FF, FF, D, (bf16_t*)(ws + W_MLP2) + (size_t)l * D * FF, scr, lane, gw, NGW, base);
        }
        __syncthreads();
        } SEAM(0);
    }
    if (IN(1)) { REPLOOP(1) { PH_BEGIN();
        for (size_t i = gtid; i < (size_t)4 * 5 * MODW; i += NGT) { const int n = (int)(i % MODW); const int l = (int)(i / (5 * MODW));
            float s = INP(I_ADAB)[l * MODW + n];
#pragma unroll
            for (int ks = 0; ks < 8; ++ks) s += PART[(size_t)ks * 4 * 5 * MODW + i];
            MOD[i] = s; }
        for (size_t i = gtid; i < 2 * D; i += NGT) { const float lam = INP(I_LLAM)[i]; const float x = ex2(-lam * LOG2E);
            const float sp = x < 0.05f ? x * (1.f + x * (-0.5f + x * (1.f / 3.f + x * (-0.25f + x * (0.2f - x * (1.f / 6.f)))))) : logf(1.f + x);
            SP[i] = -8.f * sp; }
        } SEAM(1);
    }
    if (IN(2)) { REPLOOP(2) { PH_BEGIN();
        for (size_t i = gtid; i < (size_t)R * (D / 4); i += NGT) { const int row = (int)(i >> 9), c4 = (int)(i & 511) * 4;
            const f32x4 v = row < RL ? *(const f32x4*)(INP(I_X) + (size_t)row * D + c4) : *(const f32x4*)(INP(I_CTX) + (size_t)(row - RL) * D + c4);
            const float* mp = MOD + (size_t)mod_row(row) * MODW; const f32x4 sh = *(const f32x4*)(mp + c4), sc = *(const f32x4*)(mp + D + c4);
            *(f32x4*)(Hs + (size_t)row * D + c4) = v; *(u32x2*)(Us + (size_t)row * D + c4) = pk4(v * (sc + 1.f) + sh); }
        } SEAM(2);
    }

#pragma unroll 1
    for (int layer = 0; layer < DEPTH; ++layer) {
        const int Lb = 3 + 12 * layer;
        const int nrows = layer == DEPTH - 1 ? RL : R;
#define LAYER_VARS() const float* modl = MOD + (size_t)layer * 5 * MODW; (void)modl; \
        const bf16_t* YIN = (const bf16_t*)(ws + (layer == 0 ? X_YIN : layer == 1 ? X_DO : layer == 2 ? X_RO : X_AO)); (void)YIN; \
        const bf16_t* WOUT = (const bf16_t*)(ws + (layer == 0 ? W_LRU_OUT : layer == 1 ? W_DIF_OUT : layer == 2 ? W_RET_OUT : W_SWA_OUT)); (void)WOUT;

        if (layer == 0) {
#define LRU_VARS() bf16_t* GG = (bf16_t*)(ws + X_GG); float* REC = (float*)(ws + X_REC); bf16_t* XCB = (bf16_t*)(ws + X_XCB); float* XCF = (float*)(ws + X_XCF); \
            float* AB = (float*)(ws + X_AB); float* BB = (float*)(ws + X_BB); float* CAR = (float*)(ws + X_CARRY); bf16_t* YO = (bf16_t*)(ws + X_YIN); \
            (void)GG; (void)REC; (void)XCB; (void)XCF; (void)AB; (void)BB; (void)CAR; (void)YO;
            if (IN(Lb + 0)) { REPLOOP(Lb + 0) { PH_BEGIN(); ph_lru_in(lds, tid, ws, G, bid); } SEAM(Lb + 0); }
            if (IN(Lb + 1)) { REPLOOP(Lb + 1) { PH_BEGIN(); LRU_VARS();
                const float* cw = INP(I_LCW); const float* cb = INP(I_LCB);
                for (size_t i = gtid; i < (size_t)R * (D / 4); i += NGT) { const int row = (int)(i >> 9), c4 = (int)(i & 511) * 4;
                    const int t = row < RL ? (row & (SEQ - 1)) : ((row - RL) & (CTX - 1)), len = row < RL ? SEQ : CTX;
                    f32x4 a = *(const f32x4*)(cb + c4);
#pragma unroll
                    for (int k = 0; k < 4; ++k) { const int tt = t + k - 2; if (tt >= 0 && tt < len) a += *(const f32x4*)(cw + k * D + c4) * *(const f32x4*)(REC + (size_t)(row + k - 2) * D + c4); }
                    *(f32x4*)(XCF + (size_t)row * D + c4) = a; *(u32x2*)(XCB + (size_t)row * D + c4) = pk4(a); }
                } SEAM(Lb + 1);
            }
            if (IN(Lb + 2)) { REPLOOP(Lb + 2) { PH_BEGIN(); ph_lru_gate(lds, tid, ws, INP(I_LGB), G, bid); } SEAM(Lb + 2); }
            if (IN(Lb + 3)) { REPLOOP(Lb + 3) { PH_BEGIN(); LRU_VARS();
                LAS float* Al = (LAS float*)lds; LAS float* Bl = (LAS float*)(lds + 65536); LAS float* seg = (LAS float*)(lds + RING_BYTES + 1024);
                bf16_t* PC = (bf16_t*)(ws + X_PC); bf16_t* HL = (bf16_t*)(ws + X_HL);
                const int ch = tid & 63, sg = tid >> 6;
#pragma unroll 1
                for (int task = bid; task < 2 * 36 * 32; task += G) { const int cg = task & 31, pm = (task >> 5) % 36, dir = task / (36 * 32); const int ch0 = cg * 64;
                    const float* ag = AB + ((size_t)dir * R + pm * 256) * D + ch0; const float* bg = BB + ((size_t)dir * R + pm * 256) * D + ch0;
#pragma unroll
                    for (int i = 0; i < 8; ++i) { const int e = tid + 512 * i, r = e >> 4, c4 = (e & 15) * 4;
                        *(LAS f32x4*)(Al + r * 64 + c4) = *(const f32x4*)(ag + (size_t)r * D + c4); *(LAS f32x4*)(Bl + r * 64 + c4) = *(const f32x4*)(bg + (size_t)r * D + c4); }
                    __syncthreads();
                    float p = 1.f, h = 0.f;
#pragma unroll 8
                    for (int i = 0; i < 32; ++i) { const int r = dir == 0 ? 32 * sg + i : 255 - (32 * sg + i); const float a = Al[r * 64 + ch], b = Bl[r * 64 + ch]; p *= a; h = a * h + b; Al[r * 64 + ch] = p; Bl[r * 64 + ch] = h; }
                    seg[(sg * 64 + ch) * 2] = p; seg[(sg * 64 + ch) * 2 + 1] = h;
                    __syncthreads();
                    float cp = 1.f, chh = 0.f;
                    for (int k = 0; k < sg; ++k) { const float sp_ = seg[(k * 64 + ch) * 2], sh_ = seg[(k * 64 + ch) * 2 + 1]; chh = sp_ * chh + sh_; cp *= sp_; }
                    if (sg == 7) { float* cpz = CAR + ((size_t)(dir * 36 + pm) * 2) * D + ch0 + ch; cpz[0] = cp * p; cpz[D] = p * chh + h; }
                    const size_t ob = ((size_t)dir * R + pm * 256) * D + ch0 + ch;
#pragma unroll 8
                    for (int i = 0; i < 32; ++i) { const int r = dir == 0 ? 32 * sg + i : 255 - (32 * sg + i); const float pl = Al[r * 64 + ch], hl = Bl[r * 64 + ch];
                        PC[ob + (size_t)r * D] = f2bf(pl * cp); HL[ob + (size_t)r * D] = f2bf(hl + pl * chh); }
                    __syncthreads();
                }
                } SEAM(Lb + 3);
            }
            if (IN(Lb + 4)) { REPLOOP(Lb + 4) { PH_BEGIN(); LRU_VARS();
                float* CIN = (float*)(ws + X_CIN);
                for (size_t i = gtid; i < (size_t)NB * 2 * D; i += NGT) { const int ch = (int)(i & (D - 1)), dir = (int)(i >> 11) & 1, b = (int)(i >> 12);
                    float h = 0.f;
#pragma unroll 1
                    for (int s = 0; s < 9; ++s) { const int pm = s == 0 ? 32 + b : (dir == 0 ? b * 8 + (s - 1) : b * 8 + (8 - s));
                        CIN[((size_t)dir * 36 + pm) * D + ch] = h; const float* cp = CAR + ((size_t)(dir * 36 + pm) * 2) * D + ch; h = cp[0] * h + cp[D]; } }
                } SEAM(Lb + 4);
            }
            if (IN(Lb + 5)) { REPLOOP(Lb + 5) { PH_BEGIN(); LRU_VARS();
                const float* CIN = (const float*)(ws + X_CIN); const bf16_t* PC = (const bf16_t*)(ws + X_PC); const bf16_t* HL = (const bf16_t*)(ws + X_HL);
                for (size_t i = gtid; i < (size_t)R * (D / 4); i += NGT) { const int row = (int)(i >> 9), c4 = (int)(i & 511) * 4, pm = row >> 8; const size_t o = (size_t)row * D + c4;
                    const u32x2 pf = *(const u32x2*)(PC + o), hf = *(const u32x2*)(HL + o), pb = *(const u32x2*)(PC + (size_t)R * D + o), hb = *(const u32x2*)(HL + (size_t)R * D + o), gg = *(const u32x2*)(GG + o);
                    const f32x4 cf = *(const f32x4*)(CIN + (size_t)pm * D + c4), cb = *(const f32x4*)(CIN + ((size_t)36 + pm) * D + c4);
#define UNPK(w) (f32x4){__uint_as_float((w).x << 16), __uint_as_float((w).x & 0xffff0000u), __uint_as_float((w).y << 16), __uint_as_float((w).y & 0xffff0000u)}
                    const f32x4 y = UNPK(gg) * ((UNPK(hf) + UNPK(pf) * cf) + (UNPK(hb) + UNPK(pb) * cb));
#undef UNPK
                    *(u32x2*)(YO + o) = pk4(y); }
                } SEAM(Lb + 5);
            }
        } else if (layer == 1) {
            if (IN(Lb + 0)) { REPLOOP(Lb + 0) { PH_BEGIN(); ph_qkv(lds, tid, ws, 0, G, bid); } SEAM(Lb + 0); }
            if (IN(Lb + 1)) { REPLOOP(Lb + 1) { PH_BEGIN(); ph_attn_dif(lds, tid, ws, G, bid); } SEAM(Lb + 1); }
            if (IN(Lb + 2)) { REPLOOP(Lb + 2) { PH_BEGIN(); float* OD = (float*)(ws + X_OD); bf16_t* DO = (bf16_t*)(ws + X_DO);
                const float* dl = INP(I_DLAM); const float lam_init = 0.8f - 0.6f * 0.7408182206817179f;
                const float s1 = wave_sum(dl[lane] * dl[64 + lane]), s2 = wave_sum(dl[128 + lane] * dl[192 + lane]);
                const float lamf = expf(s1) - expf(s2) + lam_init;
                const f32x4 sub = *(const f32x4*)(INP(I_DSUB) + ((lane & 31) * 4)) * (1.f - lam_init);
                for (int row = gw; row < R; row += NGW) {
#pragma unroll
                    for (int j = 0; j < 8; ++j) { const size_t o = (size_t)row * D + j * 256 + lane * 4; const f32x4 v = *(const f32x4*)(OD + o) - *(const f32x4*)(OD + (size_t)R * D + o) * lamf;
                        float ss = (v[0] * v[0] + v[1] * v[1]) + (v[2] * v[2] + v[3] * v[3]);
#pragma unroll
                        for (int x = 1; x < 32; x <<= 1) ss += __shfl_xor(ss, x);
                        const float rs = 1.f / sqrtf(ss * (1.f / 128.f) + LN_EPS);
                        *(u32x2*)(DO + o) = pk4(v * rs * sub); }
                }
                } SEAM(Lb + 2);
            }
        } else if (layer == 2) {
            if (IN(Lb + 0)) { REPLOOP(Lb + 0) { PH_BEGIN(); ph_ret_qkvg(lds, tid, ws, G, bid); } SEAM(Lb + 0); }
            if (IN(Lb + 1)) { REPLOOP(Lb + 1) { PH_BEGIN(); ph_ret_s(lds, tid, ws, G, bid); } SEAM(Lb + 1); }
            if (IN(Lb + 2)) { REPLOOP(Lb + 2) { PH_BEGIN(); ph_ret_kv(lds, tid, ws, G, bid); } SEAM(Lb + 2); }
            if (IN(Lb + 3)) { REPLOOP(Lb + 3) { PH_BEGIN(); bf16_t* B3 = (bf16_t*)(ws + X_B3); float* KVT = (float*)(ws + X_KVT);
                for (size_t i = gtid; i < (size_t)64 * 32768; i += NGT) { const int e4 = (int)(i & 32767), hd = (int)(i >> 15) & 15, b = (int)(i >> 19);
                    const int h = hd >> 1, dir = hd & 1; const int dv = e4 >> 6, dk = (e4 & 63) * 4;
                    const float cdec = ex2(256.f * ret_log2g(dir ? 7 - h : h));
                    f32x4 acc = {0.f, 0.f, 0.f, 0.f};
#pragma unroll 1
                    for (int s = 0; s < 9; ++s) { const int pm = s == 0 ? 32 + b : (dir == 0 ? b * 8 + (s - 1) : b * 8 + (8 - s));
                        *(u32x2*)(B3 + (((size_t)pm * 8 + h) * 512 + dv) * 768 + dir * 256 + dk) = pk4(acc);
                        acc = acc * cdec + *(const f32x4*)(KVT + (((size_t)pm * 16 + hd) * 512 + dv) * 256 + dk); }
                }
                } SEAM(Lb + 3);
            }
            if (IN(Lb + 4)) { REPLOOP(Lb + 4) { PH_BEGIN(); ph_ret_out(lds, tid, ws, G, bid); } SEAM(Lb + 4); }
            if (IN(Lb + 5)) { REPLOOP(Lb + 5) { PH_BEGIN(); float* O2 = (float*)(ws + X_O2); bf16_t* RO = (bf16_t*)(ws + X_RO); bf16_t* SG = (bf16_t*)(ws + X_SG);
                for (int row = gw; row < R; row += NGW) {
#pragma unroll
                    for (int hh = 0; hh < 8; ++hh) { const size_t o = (size_t)row * 4096 + hh * 512 + lane * 4; const f32x4 v0 = *(const f32x4*)(O2 + o), v1 = *(const f32x4*)(O2 + o + 256);
                        const float ss = wave_sum((v0[0] * v0[0] + v0[1] * v0[1]) + (v0[2] * v0[2] + v0[3] * v0[3]) + (v1[0] * v1[0] + v1[1] * v1[1]) + (v1[2] * v1[2] + v1[3] * v1[3]));
                        const float rs = 1.f / sqrtf(ss * (1.f / 512.f) + LN_EPS);
                        const u32x2 g0 = *(const u32x2*)(SG + o), g1 = *(const u32x2*)(SG + o + 256);
                        f32x4 ga, gb2; ga[0] = __uint_as_float(g0.x << 16); ga[1] = __uint_as_float(g0.x & 0xffff0000u); ga[2] = __uint_as_float(g0.y << 16); ga[3] = __uint_as_float(g0.y & 0xffff0000u);
                        gb2[0] = __uint_as_float(g1.x << 16); gb2[1] = __uint_as_float(g1.x & 0xffff0000u); gb2[2] = __uint_as_float(g1.y << 16); gb2[3] = __uint_as_float(g1.y & 0xffff0000u);
                        *(u32x2*)(RO + o) = pk4(v0 * rs * ga); *(u32x2*)(RO + o + 256) = pk4(v1 * rs * gb2); }
                }
                } SEAM(Lb + 5);
            }
        } else {
            if (IN(Lb + 0)) { REPLOOP(Lb + 0) { PH_BEGIN(); ph_qkv(lds, tid, ws, 1, G, bid); } SEAM(Lb + 0); }
            if (IN(Lb + 1)) { REPLOOP(Lb + 1) { PH_BEGIN(); ph_attn_swa(lds, tid, ws, INP(I_SSINK), G, bid); } SEAM(Lb + 1); }
        }

        if (IN(Lb + 7)) { REPLOOP(Lb + 7) { PH_BEGIN(); LAYER_VARS(); if (layer == 2) ph_resid<4096>(lds, tid, ws, YIN, WOUT, nrows, modl + 2 * D, G, bid); else ph_resid<D>(lds, tid, ws, YIN, WOUT, nrows, modl + 2 * D, G, bid); } SEAM(Lb + 7); }
#pragma unroll 1
        for (int which = 0; which < 2; ++which) {
            if (which == 1) {
                if (IN(Lb + 9)) { REPLOOP(Lb + 9) { PH_BEGIN(); ph_up(lds, tid, ws, layer, nrows, G, bid); } SEAM(Lb + 9); }
                if (IN(Lb + 10)) { REPLOOP(Lb + 10) { PH_BEGIN(); LAYER_VARS(); ph_resid<FF>(lds, tid, ws, (const bf16_t*)(ws + X_ACT), (const bf16_t*)(ws + W_MLP2) + (size_t)layer * D * FF, nrows, modl + 5 * D, G, bid); } SEAM(Lb + 10); }
            }
            const int pid = Lb + (which == 0 ? 8 : 11);
            if (IN(pid)) { REPLOOP(pid) { PH_BEGIN(); LAYER_VARS();
                const float* lg = INP(I_LNG) + (size_t)(layer * 2 + which) * D; const float* lb = INP(I_LNB) + (size_t)(layer * 2 + which) * D;
                const bool fin = (layer == DEPTH - 1 && which == 1);
                const float* mbase = which == 0 ? modl + 3 * D : modl + 5 * MODW;
                for (int t = gw; t < 2048; t += NGW) {
                  int r0, nr, rc = -1;
                  if (nrows == RL) { r0 = 4 * t; nr = 4; } else if (t < 1024) { rc = RL + t; r0 = 3 * t; nr = 3; } else { r0 = 3072 + (t - 1024) * 5; nr = 5; }
#pragma unroll 1
                  for (int q = (rc >= 0 ? -1 : 0); q < nr; ++q) { const int row = q < 0 ? rc : r0 + q;
                    const float* tp = Ts + (size_t)row * D + lane * 4;
                    f32x4 v[8]; float s = 0.f;
if (row < RL) {
#pragma unroll
                        for (int j = 0; j < 8; ++j) v[j] = *(const f32x4*)(tp + 256 * j);
                    } else {
                        const float* hp0 = Hs + (size_t)row * D + lane * 4; const float* gp = modl + 4 * MODW + (which == 0 ? 2 : 5) * D + lane * 4;
                        const float* pk = (const float*)(ws + X_PARTK) + (size_t)(row - RL) * D + lane * 4;
#pragma unroll
                        for (int j = 0; j < 8; ++j) { f32x4 a = *(const f32x4*)(pk + 256 * j);
#pragma unroll
                            for (int ks = 1; ks < 8; ++ks) a += *(const f32x4*)(pk + (size_t)ks * RC * D + 256 * j);
                            v[j] = *(const f32x4*)(hp0 + 256 * j) * ALPHA + *(const f32x4*)(gp + 256 * j) * a; }
                    }
#pragma unroll
                    for (int j = 0; j < 8; ++j) s += (v[j][0] + v[j][1]) + (v[j][2] + v[j][3]);
                    const float mean = wave_sum(s) * (1.f / D); float s2 = 0.f;
#pragma unroll
                    for (int j = 0; j < 8; ++j) { v[j] = v[j] - mean; s2 += (v[j][0] * v[j][0] + v[j][1] * v[j][1]) + (v[j][2] * v[j][2] + v[j][3] * v[j][3]); }
                    const float rstd = 1.f / sqrtf(wave_sum(s2) * (1.f / D) + LN_EPS);
                    const float* mp = mbase + (size_t)mod_row(row) * MODW;
                    float* hp = (fin ? args.out : Hs) + (size_t)row * D + lane * 4;
#pragma unroll
                    for (int j = 0; j < 8; ++j) { const int c = lane * 4 + 256 * j; const f32x4 y = v[j] * rstd * *(const f32x4*)(lg + c) + *(const f32x4*)(lb + c);
                        *(f32x4*)(hp + 256 * j) = y;
                        if (!fin) { const f32x4 sh = *(const f32x4*)(mp + c), sc = *(const f32x4*)(mp + D + c); *(u32x2*)(Us + (size_t)row * D + c) = pk4(y * (sc + 1.f) + sh); } }
                  }
                }
                } SEAM(pid);
            }
        }
    }
#undef IN
#undef SEAM
}

__global__ void marker_kernel(float* out, int n, float v) { const int i = blockIdx.x * blockDim.x + threadIdx.x; if (i < n) out[i] = v; }

static bool phase_used(int ph) {
    if (ph < 3) return true;
    const int layer = (ph - 3) / 12, k = (ph - 3) % 12;
    if (k >= 7) return true;
    const int nmix[4] = {6, 3, 6, 2};
    return k < nmix[layer];
}

extern "C" void kernel_launch(void* const* d_in, const int* in_sizes, int n_in, void* d_out, int out_size, void* d_ws, size_t ws_size, hipStream_t stream) {
    static int grid = 0;
    if (grid == 0) {
        int dev = 0, cus = 0;
        if (hipGetDevice(&dev) != hipSuccess || hipDeviceGetAttribute(&cus, hipDeviceAttributeMultiprocessorCount, dev) != hipSuccess) { grid = -1; }
        else if (hipFuncSetAttribute((const void*)fwd, hipFuncAttributeMaxDynamicSharedMemorySize, LDS_BYTES) != hipSuccess) { fprintf(stderr, "kernel_launch: hipFuncSetAttribute failed\n"); grid = -1; }
        else { int per_cu = 0; (void)hipOccupancyMaxActiveBlocksPerMultiprocessor(&per_cu, (const void*)fwd, NTHR, LDS_BYTES); (void)hipGetLastError(); grid = cus; }
    }
    if (grid < 0 || n_in != 26 || out_size != RL * D || ws_size < WS_END) {
        fprintf(stderr, "kernel_launch: bad configuration (grid %d n_in %d out %d ws %zu need %zu)\n", grid, n_in, out_size, ws_size, (size_t)WS_END);
        hipLaunchKernelGGL(marker_kernel, dim3((out_size + 255) / 256), dim3(256), 0, stream, (float*)d_out, out_size, ws_size < WS_END ? 1000.f : 3000.f);
        return;
    }
    (void)hipMemsetAsync((char*)d_ws + WS_CTL, 0, CTL_BYTES, stream);
    Args a{};
    for (int i = 0; i < 26; ++i) a.in[i] = (const float*)d_in[i];
    a.out = (float*)d_out; a.ws = (unsigned char*)d_ws;
#if MK_MULTI
    for (int ph = 0; ph < NPHASE; ++ph) { if (!phase_used(ph)) continue; a.ph_lo = ph; a.ph_hi = ph + 1; hipLaunchKernelGGL(fwd, dim3(grid), dim3(NTHR), LDS_BYTES, stream, a); }
#else
    a.ph_lo = 0; a.ph_hi = NPHASE;
    hipLaunchKernelGGL(fwd, dim3(grid), dim3(NTHR), LDS_BYTES, stream, a);
#endif
}
```

```cpp
#include <hip/hip_runtime.h>
#include <cstdio>
#include <cstdint>

#ifndef MK_MULTI
#define MK_MULTI 0
#endif

#define LAS __attribute__((address_space(3)))
#define GAS __attribute__((address_space(1)))
typedef unsigned short bf16_t;
typedef short bf16x8 __attribute__((ext_vector_type(8)));
typedef float f32x4 __attribute__((ext_vector_type(4)));
typedef float f32x2 __attribute__((ext_vector_type(2)));
typedef float f32x16 __attribute__((ext_vector_type(16)));
typedef unsigned u32x4 __attribute__((ext_vector_type(4)));
typedef unsigned u32x2 __attribute__((ext_vector_type(2)));

constexpr int D = 2048, NB = 4, SEQ = 2048, CTX = 256, DEPTH = 4, FF = 8192;
constexpr int RL = NB * SEQ, RC = NB * CTX, R = RL + RC;
constexpr int NTOK = SEQ + CTX;
constexpr float LN_EPS = 1e-5f;
constexpr float ALPHA = 1.681792830507429f;
constexpr float LOG2E = 1.4426950408889634f;
constexpr int MODW = 6 * D;

constexpr size_t MiB = (size_t)1 << 20;
constexpr size_t WS_CTL = 0, CTL_BYTES = 1 * MiB;
constexpr size_t WS_MOD = 1 * MiB;
constexpr size_t WS_SP = 2 * MiB;
constexpr size_t WS_PART = 3 * MiB;
constexpr size_t WS_W = 11 * MiB;
constexpr size_t W_LRU_IN = WS_W, W_LRU_G = WS_W + 16 * MiB, W_LRU_OUT = WS_W + 20 * MiB, W_DIF_QKV = WS_W + 28 * MiB, W_DIF_OUT = WS_W + 52 * MiB,
                 W_RET_QKVG = WS_W + 60 * MiB, W_RET_OUT = WS_W + 108 * MiB, W_SWA_QKV = WS_W + 124 * MiB, W_SWA_OUT = WS_W + 136 * MiB,
                 W_MLP1 = WS_W + 144 * MiB, W_MLP2 = WS_W + 272 * MiB;
constexpr size_t WS_H = 411 * MiB, WS_T = 483 * MiB, WS_U = 555 * MiB, WS_X = 591 * MiB;
constexpr size_t X_ACT = WS_X;
constexpr size_t X_PC = WS_X + 36 * MiB, X_HL = WS_X + 144 * MiB, X_CIN = WS_X + 508 * MiB;
constexpr size_t X_GG = WS_X, X_REC = WS_X + 36 * MiB, X_XCB = WS_X + 108 * MiB, X_XCF = WS_X + 144 * MiB, X_AB = WS_X + 216 * MiB, X_BB = WS_X + 360 * MiB,
                 X_CARRY = WS_X + 504 * MiB, X_YIN = WS_X + 512 * MiB;
constexpr size_t X_Q1 = WS_X, X_K1 = WS_X + 36 * MiB, X_VT1 = WS_X + 72 * MiB, X_OD = WS_X + 108 * MiB, X_DO = WS_X + 252 * MiB;
constexpr size_t X_Q2 = WS_X, X_K2 = WS_X + 36 * MiB, X_KTF = WS_X + 72 * MiB, X_KTB = WS_X + 108 * MiB, X_A3 = WS_X + 144 * MiB, X_B3 = WS_X + 252 * MiB,
                 X_KVT = WS_X + 468 * MiB, X_O2 = X_KVT, X_RO = WS_X, X_SG = WS_T;
constexpr size_t X_Q3 = WS_X, X_K3 = WS_X + 36 * MiB, X_VT3 = WS_X + 48 * MiB, X_AO = WS_X + 60 * MiB;
constexpr size_t X_PARTK = WS_X + 160 * MiB;
constexpr size_t WS_END = WS_X + 756 * MiB;

__device__ __forceinline__ unsigned cvt_pk_bf16(float lo, float hi) { unsigned r; asm volatile("v_cvt_pk_bf16_f32 %0, %1, %2" : "=v"(r) : "v"(lo), "v"(hi)); return r; }
__device__ __forceinline__ bf16_t f2bf(float x) { return (bf16_t)(cvt_pk_bf16(x, 0.f) & 0xffffu); }
__device__ __forceinline__ u32x2 pk4(f32x4 v) { u32x2 w; w.x = cvt_pk_bf16(v[0], v[1]); w.y = cvt_pk_bf16(v[2], v[3]); return w; }
__device__ __forceinline__ float bf2f(bf16_t u) { return __uint_as_float(((unsigned)u) << 16); }
__device__ __forceinline__ float ex2(float x) { return __builtin_amdgcn_exp2f(x); }
__device__ __forceinline__ float rcpf(float x) { return __builtin_amdgcn_rcpf(x); }
__device__ __forceinline__ float sigmoidf(float x) { return rcpf(1.f + ex2(-x * LOG2E)); }
__device__ __forceinline__ float siluf(float x) { return x * sigmoidf(x); }
__device__ __forceinline__ float gelu_tanh(float x) { const float z = 0.7978845608028654f * (x + 0.044715f * x * x * x); return x * rcpf(1.f + ex2(-2.f * LOG2E * z)); }
__device__ __forceinline__ int mod_row(int row) { return row < RL ? (row >> 11) : 4; }
__device__ __forceinline__ float wave_sum(float v) {
#pragma unroll
    for (int o = 1; o < 64; o <<= 1) v += __shfl_xor(v, o);
    return v;
}
__device__ __forceinline__ float ret_log2g(int h) {
    const float x = ex2(-5.f - (float)h);
    const float s = x * (1.f + x * (0.5f + x * (1.f / 3.f + x * (0.25f + x * (0.2f + x * (1.f / 6.f + x * (1.f / 7.f)))))));
    return -s * LOG2E;
}

namespace pg8 {
constexpr int BM = 256, BK = 64, HALF = 128, HTB = HALF * BK * 2, STAGE_BYTES = 8 * HTB, NXCD = 8, WGM = 8;
__host__ __device__ __forceinline__ int lds_byte(int r, int c) { const int st = (r >> 4) * 2 + (c >> 5), rr = r & 15, cc = c & 31, ob = rr * 64 + cc * 2; return st * 1024 + (ob ^ (((ob >> 9) & 1) << 5)); }
__host__ __device__ __forceinline__ void stage_rc(int b, int& Rr, int& C) { const int st = b / 1024, sb = b % 1024, swz = sb ^ (((sb >> 9) & 1) << 5); Rr = (st >> 1) * 16 + swz / 64; C = (st & 1) * 32 + (swz % 64) / 2; }

struct Unit { const char* a; const char* b; int pm, pn, nt, aux; };

template <class Map> struct Order {
    int nM, nN, nwg, G, c, nt; Map map;
    __device__ __forceinline__ void init(int nM_, int nN_, int G_, int c_, int K_, const Map& m) { nM = nM_; nN = nN_; nwg = nM_ * nN_; G = G_; c = c_; nt = K_ / BK; map = m; }
    __device__ __forceinline__ bool next(int i, Unit& u) const {
        const long Lx = (long)i * G + c; if (Lx >= nwg) return false;
        int wgid = (int)Lx; { const int q = nwg / NXCD, r = nwg % NXCD, xcd = wgid % NXCD, off = wgid / NXCD; wgid = (xcd < r ? xcd * (q + 1) : r * (q + 1) + (xcd - r) * q) + off; }
        const int nig = WGM * nN, gid = wgid / nig, fm = gid * WGM, gsz = (nM - fm) < WGM ? (nM - fm) : WGM;
        u.pm = fm + ((wgid % nig) % gsz); u.pn = (wgid % nig) / gsz; u.nt = nt; u.aux = 0; map(u); return true;
    }
};

template <class Epi, class Sched, bool ALIGN_EPI>
__device__ __forceinline__ void gemm_phase(LAS unsigned char* lds, const int tid, const int K, const int lda, const int ldb, const Sched& S, const Epi& E) {
    const int wid = __builtin_amdgcn_readfirstlane(tid >> 6), lane = tid & 63, wr = wid >> 2, wc = wid & 3, fr = lane & 15, fq = lane >> 4;
    unsigned voffA[2], voffB[2];
#pragma unroll
    for (int i = 0; i < 2; ++i) { int Rr, C; stage_rc(tid * 16 + i * 8192, Rr, C); voffA[i] = (unsigned)(Rr * lda + C) * 2u; voffB[i] = (unsigned)(Rr * ldb + C) * 2u; }
    const size_t kstep = (size_t)(BK * 2);
    const size_t hstepA = (size_t)HALF * lda * 2, hstepB = (size_t)HALF * ldb * 2;
    const unsigned ldsw = (unsigned)wid * 1024u;
    const int aoff = lds_byte(wr * 64 + fr, fq * 8), boff = lds_byte(wc * 32 + fr, fq * 8);
#define PG8_SA(b, h) (((b) * 2 + (h)) * HTB)
#define PG8_SB(b, h) ((4 + (b) * 2 + (h)) * HTB)
#define PG8_STAGE(bufoff, gbase, voff) do { _Pragma("unroll") for (int _i = 0; _i < 2; ++_i) \
        __builtin_amdgcn_global_load_lds((const unsigned*)((const char*)(gbase) + (voff)[_i]), (LAS unsigned*)(lds + (bufoff) + ldsw + _i * 8192), 16, 0, 0); } while (0)
#define PG8_LDA(dst, b, h) do { _Pragma("unroll") for (int m = 0; m < 4; ++m) _Pragma("unroll") for (int k = 0; k < 2; ++k) dst[m][k] = *(const LAS bf16x8*)(lds + PG8_SA(b, h) + aoff + m * 2048 + k * 1024); } while (0)
#define PG8_LDB(dst, b, h) do { _Pragma("unroll") for (int n = 0; n < 2; ++n) _Pragma("unroll") for (int k = 0; k < 2; ++k) dst[n][k] = *(const LAS bf16x8*)(lds + PG8_SB(b, h) + boff + n * 2048 + k * 1024); } while (0)
#define PG8_MMA(ai, bj, At, Bt) do { __builtin_amdgcn_s_setprio(1); _Pragma("unroll") for (int m = 0; m < 4; ++m) _Pragma("unroll") for (int n = 0; n < 2; ++n) _Pragma("unroll") for (int k = 0; k < 2; ++k) \
        acc[ai][bj][m][n] = __builtin_amdgcn_mfma_f32_16x16x32_bf16(Bt[n][k], At[m][k], acc[ai][bj][m][n], 0, 0, 0); __builtin_amdgcn_s_setprio(0); } while (0)
#define PG8_WAIT_V(n) asm volatile("s_waitcnt vmcnt(" #n ")" ::: "memory")
#define PG8_WAIT_L(n) asm volatile("s_waitcnt lgkmcnt(" #n ")" ::: "memory")
#define PG8_BAR __builtin_amdgcn_s_barrier()
#define PG8_SCHED __builtin_amdgcn_sched_barrier(0)
    Unit cur, nxt; int ui = 0;
    if (!S.next(0, cur)) return;
    f32x4 acc[2][2][4][2];
#pragma unroll
    for (int a = 0; a < 2; ++a)
#pragma unroll
        for (int b = 0; b < 2; ++b)
#pragma unroll
            for (int m = 0; m < 4; ++m)
#pragma unroll
                for (int n = 0; n < 2; ++n) acc[a][b][m][n] = (f32x4){0.f, 0.f, 0.f, 0.f};
    bf16x8 At[4][2], B0[2][2], B1[2][2];
    const char* cA = cur.a; const char* cB = cur.b;
    PG8_STAGE(PG8_SB(0, 0), cB, voffB); PG8_STAGE(PG8_SB(0, 1), cB + hstepB, voffB); PG8_STAGE(PG8_SA(0, 0), cA, voffA); PG8_STAGE(PG8_SA(0, 1), cA + hstepA, voffA);
    if (wr == 1) PG8_BAR;
    PG8_WAIT_V(2); PG8_BAR;
    PG8_STAGE(PG8_SB(1, 0), cB + kstep, voffB); PG8_STAGE(PG8_SA(1, 0), cA + kstep, voffA); PG8_STAGE(PG8_SB(1, 1), cB + hstepB + kstep, voffB);
    PG8_WAIT_V(6); PG8_BAR;
#pragma unroll 1
    for (;;) {
        const bool has_next = S.next(ui + 1, nxt);
        const char* nA = has_next ? nxt.a : cA; const char* nB = has_next ? nxt.b : cB; const int nt = cur.nt;
#pragma unroll 1
        for (int t = 0; t < nt; t += 2) {
            const bool last = (t == nt - 2);
            const char* a1 = cA + (size_t)(t + 1) * kstep;
            const char* a2 = last ? nA : cA + (size_t)(t + 2) * kstep; const char* b2 = last ? nB : cB + (size_t)(t + 2) * kstep;
            const char* a3 = a2 + kstep; const char* b3 = b2 + kstep;
            PG8_LDB(B0, 0, 0); PG8_LDB(B1, 0, 1); PG8_SCHED; PG8_LDA(At, 0, 0); PG8_STAGE(PG8_SA(1, 1), a1 + hstepA, voffA);
            PG8_WAIT_V(8); PG8_WAIT_L(0); PG8_BAR; PG8_MMA(0, 0, At, B0); PG8_MMA(0, 1, At, B1); PG8_BAR; PG8_SCHED;
            PG8_LDA(At, 0, 1); PG8_STAGE(PG8_SB(0, 0), b2, voffB); PG8_STAGE(PG8_SB(0, 1), b2 + hstepB, voffB); PG8_STAGE(PG8_SA(0, 0), a2, voffA);
            PG8_WAIT_V(8); PG8_WAIT_L(0); PG8_BAR; PG8_MMA(1, 0, At, B0); PG8_MMA(1, 1, At, B1); PG8_BAR; PG8_SCHED;
            PG8_LDB(B0, 1, 0); PG8_LDB(B1, 1, 1); PG8_SCHED; PG8_LDA(At, 1, 0); PG8_STAGE(PG8_SA(0, 1), a2 + hstepA, voffA);
            PG8_WAIT_V(8); PG8_WAIT_L(0); PG8_BAR; PG8_MMA(0, 0, At, B0); PG8_MMA(0, 1, At, B1); PG8_BAR; PG8_SCHED;
            PG8_LDA(At, 1, 1); PG8_STAGE(PG8_SB(1, 0), b3, voffB); PG8_STAGE(PG8_SB(1, 1), b3 + hstepB, voffB); PG8_STAGE(PG8_SA(1, 0), a3, voffA);
            PG8_WAIT_V(8); PG8_WAIT_L(0); PG8_BAR; PG8_MMA(1, 0, At, B0); PG8_MMA(1, 1, At, B1); PG8_BAR; PG8_SCHED;
        }
        if constexpr (ALIGN_EPI) { if (wr == 0) PG8_BAR; }
        { int efr = fr, efq = fq, ewr = wr, ewc = wc; asm volatile("" : "+v"(efr), "+v"(efq), "+s"(ewr), "+s"(ewc));
          E(acc, cur, ewr, ewc, efr, efq); }
        if (!has_next) break;
#pragma unroll
        for (int a = 0; a < 2; ++a)
#pragma unroll
            for (int b = 0; b < 2; ++b)
#pragma unroll
                for (int m = 0; m < 4; ++m)
#pragma unroll
                    for (int n = 0; n < 2; ++n) acc[a][b][m][n] = (f32x4){0.f, 0.f, 0.f, 0.f};
        cur = nxt; cA = nA; cB = nB; ++ui;
        if constexpr (ALIGN_EPI) { if (wr == 1) PG8_BAR; }
    }
    PG8_WAIT_V(0);
    if constexpr (!ALIGN_EPI) { if (wr == 0) PG8_BAR; }
    PG8_BAR;
#undef PG8_SA
#undef PG8_SB
#undef PG8_STAGE
#undef PG8_LDA
#undef PG8_LDB
#undef PG8_MMA
#undef PG8_WAIT_V
#undef PG8_WAIT_L
#undef PG8_BAR
#undef PG8_SCHED
}
}
using pg8::Unit;
typedef f32x4 Acc[2][2][4][2];
#define EPI_ROWS(ai, m) _Pragma("unroll") for (int ai = 0; ai < 2; ++ai) _Pragma("unroll") for (int m = 0; m < 4; ++m)
#define EPI_COLS(bj, n) _Pragma("unroll") for (int bj = 0; bj < 2; ++bj) _Pragma("unroll") for (int n = 0; n < 2; ++n)

struct MapPlain { const char* A; const char* B; size_t astep, bstep;
    __device__ __forceinline__ void operator()(Unit& u) const { u.a = A + (size_t)u.pm * astep; u.b = B + (size_t)u.pn * bstep; } };
struct MapLruGate { const char* XC; const char* WG;
    __device__ __forceinline__ void operator()(Unit& u) const { const int blk = (u.pn >> 1) & 7; u.a = XC + ((size_t)u.pm * 256 * D + blk * 256) * 2; u.b = WG + (size_t)u.pn * 256 * 256 * 2; } };
struct MapRetS { const char* Q; const char* Kk;
    __device__ __forceinline__ void operator()(Unit& u) const { const size_t o = ((size_t)u.pm * 256 * D + u.pn * 256) * 2; u.a = Q + o; u.b = Kk + o; } };
struct MapRetKV { const char* B3; const char* KTf; const char* KTb;
    __device__ __forceinline__ void operator()(Unit& u) const { const int half = u.pn & 1, dir = (u.pn >> 1) & 1, h = u.pn >> 2; const size_t ph = (size_t)u.pm * 8 + h;
        u.a = B3 + ((ph * 512 + half * 256) * 768 + 512) * 2; u.b = (dir ? KTb : KTf) + ph * 256 * 256 * 2; } };
struct MapRetOut { const char* A3; const char* B3;
    __device__ __forceinline__ void operator()(Unit& u) const { const int half = u.pn & 1, h = u.pn >> 1; const size_t ph = (size_t)u.pm * 8 + h;
        u.a = A3 + ((size_t)u.pm * 256 * 8 + h) * 768 * 2; u.b = B3 + (ph * 512 + half * 256) * 768 * 2; } };

struct OrderResid {
    const char* A; const char* W; int K, nfullM, nsplitM, G, c;
    __device__ __forceinline__ bool next(int i, Unit& u) const {
        const int L = i * G + c, nfull = nfullM * 8;
        if (L < nfull) { int wgid = L; { const int q = nfull / 8, xcd = wgid % 8, off = wgid / 8; wgid = xcd * q + off; }
            const int nig = 8 * 8, gid = wgid / nig, fm = gid * 8; u.pm = fm + ((wgid % nig) % 8); u.pn = (wgid % nig) / 8; u.nt = K / 64; u.aux = 0;
            u.a = A + (size_t)u.pm * 256 * K * 2; u.b = W + (size_t)u.pn * 256 * K * 2; return true; }
        const int s = L - nfull; if (s >= nsplitM * 64) return false;
        const int xcd = s & 7, j = s >> 3, combo = (xcd * nsplitM * 8) / 8 + (j >> 3), pn = j & 7, cp = combo >> 3, ks = combo & 7;
        u.pm = nfullM + cp; u.pn = pn; u.nt = K / 512; u.aux = 1 + ks;
        u.a = A + ((size_t)u.pm * 256 * K + ks * (K / 8)) * 2; u.b = W + ((size_t)pn * 256 * K + ks * (K / 8)) * 2; return true;
    }
};
struct EpiResid {
    const float* H; float* T; const float* gate; float* PARTK;
    __device__ __forceinline__ void operator()(const Acc& acc, const Unit& u, int wr, int wc, int fr, int fq) const {
        if (u.aux == 0) {
            EPI_ROWS(ai, m) { const int row = u.pm * 256 + ai * 128 + wr * 64 + m * 16 + fr; const float* gp = gate + (size_t)mod_row(row) * MODW;
                EPI_COLS(bj, n) { const int col = u.pn * 256 + bj * 128 + wc * 32 + n * 16 + fq * 4; const size_t o = (size_t)row * D + col;
                    const f32x4 h = *(const f32x4*)(H + o), g = *(const f32x4*)(gp + col); *(f32x4*)(T + o) = h * ALPHA + g * acc[ai][bj][m][n]; }
                asm volatile("" ::: "memory"); }
        } else {
            float* pb = PARTK + (size_t)(u.aux - 1) * RC * D;
            EPI_ROWS(ai, m) { const int row = u.pm * 256 + ai * 128 + wr * 64 + m * 16 + fr - RL;
                EPI_COLS(bj, n) { const int col = u.pn * 256 + bj * 128 + wc * 32 + n * 16 + fq * 4; *(f32x4*)(pb + (size_t)row * D + col) = acc[ai][bj][m][n]; } }
        }
    }
};
struct EpiMlpUp {
    bf16_t* O;
    __device__ __forceinline__ void operator()(const Acc& acc, const Unit& u, int wr, int wc, int fr, int fq) const {
        EPI_ROWS(ai, m) { const int row = u.pm * 256 + ai * 128 + wr * 64 + m * 16 + fr;
            EPI_COLS(bj, n) { const int col = u.pn * 256 + bj * 128 + wc * 32 + n * 16 + fq * 4; f32x4 v = acc[ai][bj][m][n];
#pragma unroll
                for (int j = 0; j < 4; ++j) { const float r = fmaxf(v[j], 0.f); v[j] = r * r; }
                *(u32x2*)(O + (size_t)row * FF + col) = pk4(v); } }
    }
};
struct EpiLruIn {
    bf16_t* GG; float* REC;
    __device__ __forceinline__ void operator()(const Acc& acc, const Unit& u, int wr, int wc, int fr, int fq) const {
        const bool isg = u.pn < 8;
        EPI_ROWS(ai, m) { const int row = u.pm * 256 + ai * 128 + wr * 64 + m * 16 + fr;
            EPI_COLS(bj, n) { const int col = (u.pn & 7) * 256 + bj * 128 + wc * 32 + n * 16 + fq * 4; f32x4 v = acc[ai][bj][m][n];
                if (isg) {
#pragma unroll
                    for (int j = 0; j < 4; ++j) v[j] = gelu_tanh(v[j]);
                    *(u32x2*)(GG + (size_t)row * D + col) = pk4(v);
                } else *(f32x4*)(REC + (size_t)row * D + col) = v; } }
    }
};
struct EpiLruGate {
    const float* XCF; const float* gb; const float* SP; bf16_t* AB; bf16_t* BB;
    __device__ __forceinline__ void operator()(const Acc& acc, const Unit& u, int wr, int wc, int fr, int fq) const {
        const int half = u.pn & 1, blk = (u.pn >> 1) & 7, dir = u.pn >> 4;
        EPI_ROWS(ai, m) { const int row = u.pm * 256 + ai * 128 + wr * 64 + m * 16 + fr;
#pragma unroll
            for (int n = 0; n < 2; ++n) { const int ch = blk * 256 + half * 128 + wc * 32 + n * 16 + fq * 4;
                const f32x4 br = *(const f32x4*)(gb + (dir * 2 + 0) * D + ch), bi = *(const f32x4*)(gb + (dir * 2 + 1) * D + ch), sp = *(const f32x4*)(SP + dir * D + ch);
                const f32x4 xc = *(const f32x4*)(XCF + (size_t)row * D + ch); const f32x4 rp = acc[ai][0][m][n] + br, ip = acc[ai][1][m][n] + bi; f32x4 av, bv;
#pragma unroll
                for (int j = 0; j < 4; ++j) { const float r = sigmoidf(rp[j]), ig = sigmoidf(ip[j]); const float la = sp[j] * r; const float a = ex2(la * LOG2E); const float y = 2.f * la;
                    const float om_p = -(y * (1.f + y * (0.5f + y * (1.f / 6.f + y * (1.f / 24.f + y * (1.f / 120.f)))))), om_e = 1.f - ex2(y * LOG2E); const float om = (y > -0.1f) ? om_p : om_e;
                    const float oa_p = -(la * (1.f + la * (0.5f + la * (1.f / 6.f + la * (1.f / 24.f + la * (1.f / 120.f)))))); av[j] = (la > -0.1f) ? oa_p : 1.f - a; bv[j] = sqrtf(fmaxf(om, 0.f)) * ig * xc[j]; }
                const size_t o = ((size_t)dir * R + row) * D + ch; *(u32x2*)(AB + o) = pk4(av); *(u32x2*)(BB + o) = pk4(bv); }
            asm volatile("" ::: "memory"); }
    }
};
struct EpiQKV {
    bf16_t* Q; bf16_t* K; bf16_t* VT; int kcols, vshift, vheads;
    __device__ __forceinline__ void operator()(const Acc& acc, const Unit& u, int wr, int wc, int fr, int fq) const {
        const int col0 = u.pn * 256; const int type = col0 < D ? 0 : (col0 < D + kcols ? 1 : 2);
        if (type < 2) {
            float revf[4];
#pragma unroll
            for (int j = 0; j < 4; ++j) revf[j] = ex2(-(float)(fq * 4 + j) * (13.287712379549449f / 16.f)) * 0.15915494309189535f;
            const float qs = type == 0 ? 0.125f * LOG2E : 1.f;
            EPI_ROWS(ai, m) { const int row = u.pm * 256 + ai * 128 + wr * 64 + m * 16 + fr; const bool lat = row < RL; const int t = row & (SEQ - 1);
                const float pos = (wc & 1) ? (float)(t & 63) : (float)(t >> 6);
                float cs[4], sn[4];
#pragma unroll
                for (int j = 0; j < 4; ++j) { const float rv = pos * revf[j]; cs[j] = lat ? __builtin_amdgcn_cosf(rv) : 1.f; sn[j] = lat ? __builtin_amdgcn_sinf(rv) : 0.f; }
#pragma unroll
                for (int bj = 0; bj < 2; ++bj) { const f32x4 x0 = acc[ai][bj][m][0], x1 = acc[ai][bj][m][1]; f32x4 y0, y1;
#pragma unroll
                    for (int j = 0; j < 4; ++j) { y0[j] = (x0[j] * cs[j] - x1[j] * sn[j]) * qs; y1[j] = (x1[j] * cs[j] + x0[j] * sn[j]) * qs; }
                    const int col = col0 + bj * 128 + wc * 32 + fq * 4;
                    if (type == 0) { bf16_t* p = Q + (size_t)row * D + col; *(u32x2*)p = pk4(y0); *(u32x2*)(p + 16) = pk4(y1); }
                    else { bf16_t* p = K + (size_t)row * kcols + (col - D); *(u32x2*)p = pk4(y0); *(u32x2*)(p + 16) = pk4(y1); } } }
        } else {
            EPI_ROWS(ai, m) { const int row = u.pm * 256 + ai * 128 + wr * 64 + m * 16 + fr; const bool lat = row < RL;
                const int b = lat ? (row >> 11) : ((row - RL) >> 8), tk = lat ? (row & (SEQ - 1)) : (SEQ + ((row - RL) & (CTX - 1)));
                EPI_COLS(bj, n) { const int vc = col0 - D - kcols + bj * 128 + wc * 32 + n * 16 + fq * 4; const int hh = vc >> vshift, e = vc & ((1 << vshift) - 1);
                    bf16_t* p = VT + ((size_t)(b * vheads + hh) * (1 << vshift) + e) * NTOK + tk; const f32x4 v = acc[ai][bj][m][n];
#pragma unroll
                    for (int j = 0; j < 4; ++j) p[(size_t)j * NTOK] = f2bf(v[j]); } }
        }
    }
};
struct EpiRetQKVG {
    bf16_t* Q2; bf16_t* K2; bf16_t* KTf; bf16_t* KTb; bf16_t* A3; bf16_t* B3; bf16_t* SG;
    __device__ __forceinline__ void operator()(const Acc& acc, const Unit& u, int wr, int wc, int fr, int fq) const {
        const int pn = u.pn;
        if (pn < 8) { const int h = pn; const float lgf = ret_log2g(h), lgb = ret_log2g(7 - h);
            EPI_ROWS(ai, m) { const int pos = ai * 128 + wr * 64 + m * 16 + fr; const int row = u.pm * 256 + pos; const float df = ex2((float)(pos + 1) * lgf), db = ex2((float)(256 - pos) * lgb);
                EPI_COLS(bj, n) { const int d = bj * 128 + wc * 32 + n * 16 + fq * 4; const f32x4 q = acc[ai][bj][m][n] * 0.0625f;
                    *(u32x2*)(Q2 + (size_t)row * D + h * 256 + d) = pk4(q); bf16_t* ap = A3 + ((size_t)row * 8 + h) * 768 + d;
                    *(u32x2*)ap = pk4(q * df); *(u32x2*)(ap + 256) = pk4(q * db); } }
        } else if (pn < 16) { const int h = pn - 8; const float lgf = ret_log2g(h), lgb = ret_log2g(7 - h);
            EPI_ROWS(ai, m) { const int pos = ai * 128 + wr * 64 + m * 16 + fr; const int row = u.pm * 256 + pos; const float df = ex2((float)(255 - pos) * lgf), db = ex2((float)pos * lgb);
                EPI_COLS(bj, n) { const int d = bj * 128 + wc * 32 + n * 16 + fq * 4; const f32x4 k = acc[ai][bj][m][n];
                    *(u32x2*)(K2 + (size_t)row * D + h * 256 + d) = pk4(k); const size_t to = (((size_t)u.pm * 8 + h) * 256 + d) * 256 + pos;
#pragma unroll
                    for (int j = 0; j < 4; ++j) { KTf[to + j * 256] = f2bf(k[j] * df); KTb[to + j * 256] = f2bf(k[j] * db); } } }
        } else if (pn < 32) { const int h = (pn - 16) >> 1, half = (pn - 16) & 1;
            EPI_ROWS(ai, m) { const int pos = ai * 128 + wr * 64 + m * 16 + fr;
                EPI_COLS(bj, n) { const int e = half * 256 + bj * 128 + wc * 32 + n * 16 + fq * 4; const f32x4 v = acc[ai][bj][m][n];
                    bf16_t* p = B3 + (((size_t)u.pm * 8 + h) * 512 + e) * 768 + 512 + pos;
#pragma unroll
                    for (int j = 0; j < 4; ++j) p[j * 768] = f2bf(v[j]); } }
        } else {
            EPI_ROWS(ai, m) { const int row = u.pm * 256 + ai * 128 + wr * 64 + m * 16 + fr;
                EPI_COLS(bj, n) { const int col = (pn - 32) * 256 + bj * 128 + wc * 32 + n * 16 + fq * 4; f32x4 v = acc[ai][bj][m][n];
#pragma unroll
                    for (int j = 0; j < 4; ++j) v[j] = siluf(v[j]);
                    *(u32x2*)(SG + (size_t)row * 4096 + col) = pk4(v); } }
        }
    }
};
struct EpiRetS {
    bf16_t* A3;
    __device__ __forceinline__ void operator()(const Acc& acc, const Unit& u, int wr, int wc, int fr, int fq) const {
        const int h = u.pn; const float lgf = ret_log2g(h), lgb = ret_log2g(7 - h);
        EPI_ROWS(ai, m) { const int i = ai * 128 + wr * 64 + m * 16 + fr; const int row = u.pm * 256 + i;
            EPI_COLS(bj, n) { const int j0 = bj * 128 + wc * 32 + n * 16 + fq * 4; f32x4 v = acc[ai][bj][m][n];
#pragma unroll
                for (int j = 0; j < 4; ++j) { const int rel = i - (j0 + j); v[j] *= rel >= 0 ? ex2((float)rel * lgf) : ex2((float)(-rel) * lgb); }
                *(u32x2*)(A3 + ((size_t)row * 8 + h) * 768 + 512 + j0) = pk4(v); } }
    }
};
struct EpiRetKV {
    float* KVT;
    __device__ __forceinline__ void operator()(const Acc& acc, const Unit& u, int wr, int wc, int fr, int fq) const {
        const int half = u.pn & 1, hd = u.pn >> 1;
        float* base = KVT + (((size_t)u.pm * 16 + hd) * 512 + half * 256) * 256;
        EPI_ROWS(ai, m) { const int r = ai * 128 + wr * 64 + m * 16 + fr;
            EPI_COLS(bj, n) { const int c = bj * 128 + wc * 32 + n * 16 + fq * 4; *(f32x4*)(base + (size_t)r * 256 + c) = acc[ai][bj][m][n]; } }
    }
};
struct EpiRetOut {
    float* O2;
    __device__ __forceinline__ void operator()(const Acc& acc, const Unit& u, int wr, int wc, int fr, int fq) const {
        EPI_ROWS(ai, m) { const int row = u.pm * 256 + ai * 128 + wr * 64 + m * 16 + fr;
            EPI_COLS(bj, n) { const int c = u.pn * 256 + bj * 128 + wc * 32 + n * 16 + fq * 4; *(f32x4*)(O2 + (size_t)row * 4096 + c) = acc[ai][bj][m][n]; } }
    }
};

template <int DV, bool OUTBF>
__device__ __forceinline__ void attn_unit(LAS unsigned char* lds, const int tid, const bf16_t* q, int ldq, const bf16_t* k0, const bf16_t* k1, int ldk,
                                          const bf16_t* vt0, const bf16_t* vt1, int ldvt, int nt0, int nt1, bool band, int qpos0, int kpos0,
                                          bool has_sink, float sink_l2, void* o, int ldo) {
    constexpr int KT_BYTES = 64 * 144, VT_BYTES = DV * 136, BUF = KT_BYTES + VT_BYTES, NV = DV / 64, NDV = DV / 32;
    const int lane = tid & 63, w = tid >> 6, c32 = lane & 31, hi = lane >> 5, srow = tid >> 3, sch = tid & 7;
    bf16x8 qf[4];
#pragma unroll
    for (int ks = 0; ks < 4; ++ks) qf[ks] = *(const bf16x8*)(q + (size_t)(32 * w + c32) * ldq + ks * 16 + hi * 8);
    f32x16 oacc[NDV];
#pragma unroll
    for (int i = 0; i < NDV; ++i)
#pragma unroll
        for (int r = 0; r < 16; ++r) oacc[i][r] = 0.f;
    float m_run = -1e30f, l_run = 0.f;
    const int ntile = nt0 + nt1;
    u32x4 kreg[2], vreg[2][NV];
#define ATT_LOAD(set, tt) do { const int t1_ = (tt); const bf16_t* kp_ = t1_ < nt0 ? k0 + (size_t)(t1_ * 64) * ldk : k1 + (size_t)((t1_ - nt0) * 64) * ldk; \
        const bf16_t* vp_ = t1_ < nt0 ? vt0 + t1_ * 64 : vt1 + (t1_ - nt0) * 64; kreg[set] = *(const u32x4*)(kp_ + (size_t)srow * ldk + sch * 8); \
        _Pragma("unroll") for (int i_ = 0; i_ < NV; ++i_) vreg[set][i_] = *(const u32x4*)(vp_ + (size_t)(srow + 64 * i_) * ldvt + sch * 8); } while (0)
    ATT_LOAD(0, 0); ATT_LOAD(1, 1);
#define ATT_STEP(set, tt) do { const int t = (tt); \
        LAS unsigned char* kb = lds + (set) * BUF; LAS unsigned char* vb = kb + KT_BYTES; \
        *(LAS u32x4*)(kb + srow * 144 + sch * 16) = kreg[set]; \
        _Pragma("unroll") for (int i = 0; i < NV; ++i) { LAS unsigned char* p = vb + (srow + 64 * i) * 136 + sch * 16; *(LAS u32x2*)p = (u32x2){vreg[set][i].x, vreg[set][i].y}; *(LAS u32x2*)(p + 8) = (u32x2){vreg[set][i].z, vreg[set][i].w}; } \
        asm volatile("s_waitcnt lgkmcnt(0)" ::: "memory"); __builtin_amdgcn_s_barrier(); asm volatile("" ::: "memory"); \
        if (t + 2 < ntile) ATT_LOAD(set, t + 2); \
        f32x16 sacc[2]; \
        _Pragma("unroll") for (int a = 0; a < 2; ++a) { \
            _Pragma("unroll") for (int r = 0; r < 16; ++r) sacc[a][r] = 0.f; \
            _Pragma("unroll") for (int ks = 0; ks < 4; ++ks) { const bf16x8 kf = *(const LAS bf16x8*)(kb + (32 * a + c32) * 144 + ks * 32 + hi * 16); sacc[a] = __builtin_amdgcn_mfma_f32_32x32x16_bf16(kf, qf[ks], sacc[a], 0, 0, 0); } } \
        if (band && t < nt0) { const int qp = qpos0 + 32 * w + c32; \
            _Pragma("unroll") for (int a = 0; a < 2; ++a) \
            _Pragma("unroll") for (int r = 0; r < 16; ++r) { const int kp = kpos0 + t * 64 + 32 * a + (r & 3) + 8 * (r >> 2) + 4 * hi; const int dlt = kp - qp; if (dlt > 128 || dlt < -128) sacc[a][r] = -INFINITY; } } \
        float mx = -INFINITY; \
        _Pragma("unroll") for (int a = 0; a < 2; ++a) \
        _Pragma("unroll") for (int r = 0; r < 16; ++r) mx = fmaxf(mx, sacc[a][r]); \
        mx = fmaxf(mx, __shfl_xor(mx, 32)); \
        const float mnew = fmaxf(m_run, mx); \
        if (__any(mnew > m_run)) { const float alpha = ex2(m_run - mnew); l_run *= alpha; \
            _Pragma("unroll") for (int i = 0; i < NDV; ++i) \
            _Pragma("unroll") for (int r = 0; r < 16; ++r) oacc[i][r] *= alpha; } \
        m_run = mnew; \
        float ls = 0.f; \
        _Pragma("unroll") for (int a = 0; a < 2; ++a) \
        _Pragma("unroll") for (int r = 0; r < 16; ++r) { const float p = ex2(sacc[a][r] - mnew); sacc[a][r] = p; ls += p; } \
        l_run += ls; \
        bf16x8 pf[4]; \
        _Pragma("unroll") for (int a = 0; a < 2; ++a) \
        _Pragma("unroll") for (int jj = 0; jj < 2; ++jj) { u32x4 wv; wv.x = cvt_pk_bf16(sacc[a][8 * jj + 0], sacc[a][8 * jj + 1]); wv.y = cvt_pk_bf16(sacc[a][8 * jj + 2], sacc[a][8 * jj + 3]); \
                wv.z = cvt_pk_bf16(sacc[a][8 * jj + 4], sacc[a][8 * jj + 5]); wv.w = cvt_pk_bf16(sacc[a][8 * jj + 6], sacc[a][8 * jj + 7]); pf[2 * a + jj] = __builtin_bit_cast(bf16x8, wv); } \
        _Pragma("unroll") for (int i = 0; i < NDV; ++i) \
        _Pragma("unroll") for (int j = 0; j < 4; ++j) { const LAS unsigned char* p = vb + (32 * i + c32) * 136 + (16 * j + 4 * hi) * 2; const u32x2 lo = *(const LAS u32x2*)p, hh = *(const LAS u32x2*)(p + 16); \
                const u32x4 wv = (u32x4){lo.x, lo.y, hh.x, hh.y}; oacc[i] = __builtin_amdgcn_mfma_f32_32x32x16_bf16(__builtin_bit_cast(bf16x8, wv), pf[j], oacc[i], 0, 0, 0); } \
    } while (0)
#pragma unroll 1
    for (int tt = 0; tt < ntile; tt += 2) { ATT_STEP(0, tt); ATT_STEP(1, tt + 1); }
#undef ATT_STEP
#undef ATT_LOAD
    float lt = l_run + __shfl_xor(l_run, 32);
    if (has_sink) lt += ex2(sink_l2 - m_run);
    const float inv = 1.f / lt;
    const int row = 32 * w + c32;
#pragma unroll
    for (int i = 0; i < NDV; ++i)
#pragma unroll
        for (int g = 0; g < 4; ++g) { const int col = 32 * i + 8 * g + 4 * hi; const f32x4 v = (f32x4){oacc[i][4 * g], oacc[i][4 * g + 1], oacc[i][4 * g + 2], oacc[i][4 * g + 3]} * inv;
            if (OUTBF) *(u32x2*)((bf16_t*)o + (size_t)row * ldo + col) = pk4(v); else *(f32x4*)((float*)o + (size_t)row * ldo + col) = v; }
    asm volatile("s_waitcnt lgkmcnt(0)" ::: "memory"); __builtin_amdgcn_s_barrier(); asm volatile("" ::: "memory");
}

constexpr int DA_KP = 272, DA_KT = 64 * DA_KP, DA_VT = 128 * 136, DA_BUF = DA_KT + DA_VT, DA_Q = 2 * DA_BUF, DA_QW = 32 * DA_KP;
__device__ __forceinline__ void attn_dif_unit(LAS unsigned char* lds, const int tid, const bf16_t* q, const bf16_t* k0, const bf16_t* k1, const bf16_t* vt0, const bf16_t* vt1,
                                              int nt0, int nt1, float lamf, const float* sub, float subscale, bf16_t* o) {
    const int lane = tid & 63, w = tid >> 6, c32 = lane & 31, hi = lane >> 5, srow = tid >> 3, sch = tid & 7;
    LAS unsigned char* qb = lds + DA_Q + w * DA_QW;
#pragma unroll
    for (int i = 0; i < 8; ++i) { int lq = lane; asm volatile("" : "+v"(lq)); const int e = lq + 64 * i, r = e >> 4, c = e & 15;
        *(LAS u32x4*)(qb + r * DA_KP + c * 16) = *(const u32x4*)((const char*)q + (unsigned)(((32 * w + r) * D + c * 8) * 2)); }
    f32x16 oacc[2][4];
#pragma unroll
    for (int m = 0; m < 2; ++m)
#pragma unroll
        for (int i = 0; i < 4; ++i)
#pragma unroll
            for (int r = 0; r < 16; ++r) oacc[m][i][r] = 0.f;
    float m_run[2] = {-1e30f, -1e30f}, l_run[2] = {0.f, 0.f};
    const int ntile = nt0 + nt1;
    u32x4 kreg[2], vreg[2];
    const unsigned koff = (unsigned)(srow * D + sch * 8) * 2u, voff = (unsigned)(srow * NTOK + sch * 8) * 2u;
#define DA_LOAD(tt) do { const int t1_ = (tt); const char* kp_ = (const char*)(t1_ < nt0 ? k0 + (size_t)(t1_ * 64) * D : k1 + (size_t)((t1_ - nt0) * 64) * D); \
        const char* vp_ = (const char*)(t1_ < nt0 ? vt0 + t1_ * 64 : vt1 + (t1_ - nt0) * 64); \
        _Pragma("unroll") for (int i_ = 0; i_ < 2; ++i_) { kreg[i_] = *(const u32x4*)(kp_ + koff + i_ * 128); vreg[i_] = *(const u32x4*)(vp_ + voff + i_ * (64 * NTOK * 2)); } } while (0)
    DA_LOAD(0);
#pragma unroll 1
    for (int t = 0; t < ntile; ++t) {
        LAS unsigned char* kb = lds + (t & 1) * DA_BUF; LAS unsigned char* vb = kb + DA_KT;
#pragma unroll
        for (int i = 0; i < 2; ++i) { *(LAS u32x4*)(kb + srow * DA_KP + (sch + 8 * i) * 16) = kreg[i];
            LAS unsigned char* p = vb + (srow + 64 * i) * 136 + sch * 16; *(LAS u32x2*)p = (u32x2){vreg[i].x, vreg[i].y}; *(LAS u32x2*)(p + 8) = (u32x2){vreg[i].z, vreg[i].w}; }
        asm volatile("s_waitcnt lgkmcnt(0)" ::: "memory"); __builtin_amdgcn_s_barrier(); asm volatile("" ::: "memory");
        if (t + 1 < ntile) DA_LOAD(t + 1);
#pragma unroll
        for (int m = 0; m < 2; ++m) {
            f32x16 sacc[2];
#pragma unroll
            for (int a = 0; a < 2; ++a) {
#pragma unroll
                for (int r = 0; r < 16; ++r) sacc[a][r] = 0.f;
#pragma unroll
                for (int ks = 0; ks < 4; ++ks) { const bf16x8 kf = *(const LAS bf16x8*)(kb + (32 * a + c32) * DA_KP + m * 128 + ks * 32 + hi * 16);
                    const bf16x8 qf = *(const LAS bf16x8*)(qb + c32 * DA_KP + m * 128 + ks * 32 + hi * 16); sacc[a] = __builtin_amdgcn_mfma_f32_32x32x16_bf16(kf, qf, sacc[a], 0, 0, 0); }
            }
            float mx = -INFINITY;
#pragma unroll
            for (int a = 0; a < 2; ++a)
#pragma unroll
                for (int r = 0; r < 16; ++r) mx = fmaxf(mx, sacc[a][r]);
            mx = fmaxf(mx, __shfl_xor(mx, 32));
            const float mnew = fmaxf(m_run[m], mx);
            { const float alpha = ex2(m_run[m] - mnew); l_run[m] *= alpha;
#pragma unroll
                for (int i = 0; i < 4; ++i)
#pragma unroll
                    for (int r = 0; r < 16; ++r) oacc[m][i][r] *= alpha; }
            m_run[m] = mnew;
            float ls = 0.f;
#pragma unroll
            for (int a = 0; a < 2; ++a)
#pragma unroll
                for (int r = 0; r < 16; ++r) { const float p = ex2(sacc[a][r] - mnew); sacc[a][r] = p; ls += p; }
            l_run[m] += ls;
            bf16x8 pf[4];
#pragma unroll
            for (int a = 0; a < 2; ++a)
#pragma unroll
                for (int jj = 0; jj < 2; ++jj) { u32x4 wv; wv.x = cvt_pk_bf16(sacc[a][8 * jj + 0], sacc[a][8 * jj + 1]); wv.y = cvt_pk_bf16(sacc[a][8 * jj + 2], sacc[a][8 * jj + 3]);
                    wv.z = cvt_pk_bf16(sacc[a][8 * jj + 4], sacc[a][8 * jj + 5]); wv.w = cvt_pk_bf16(sacc[a][8 * jj + 6], sacc[a][8 * jj + 7]); pf[2 * a + jj] = __builtin_bit_cast(bf16x8, wv); }
#pragma unroll
            for (int i = 0; i < 4; ++i)
#pragma unroll
                for (int j = 0; j < 4; ++j) { const LAS unsigned char* p = vb + (32 * i + c32) * 136 + (16 * j + 4 * hi) * 2; const u32x2 lo = *(const LAS u32x2*)p, hh = *(const LAS u32x2*)(p + 16);
                    const u32x4 wv = (u32x4){lo.x, lo.y, hh.x, hh.y}; oacc[m][i] = __builtin_amdgcn_mfma_f32_32x32x16_bf16(__builtin_bit_cast(bf16x8, wv), pf[j], oacc[m][i], 0, 0, 0); }
            __builtin_amdgcn_sched_barrier(0);
        }
    }
#undef DA_LOAD
    const float inv0 = 1.f / (l_run[0] + __shfl_xor(l_run[0], 32)), inv1 = lamf / (l_run[1] + __shfl_xor(l_run[1], 32));
    float ss = 0.f;
#pragma unroll
    for (int i = 0; i < 4; ++i)
#pragma unroll
        for (int r = 0; r < 16; ++r) { const float v = oacc[0][i][r] * inv0 - oacc[1][i][r] * inv1; oacc[0][i][r] = v; ss += v * v; }
    ss += __shfl_xor(ss, 32);
    const float rs = subscale / sqrtf(ss * (1.f / 128.f) + LN_EPS);
    int c32b = c32, hib = hi; asm volatile("" : "+v"(c32b), "+v"(hib));
    const unsigned ob = (unsigned)((32 * w + c32b) * D + 4 * hib) * 2u; const float* subp = sub + 4 * hib;
#pragma unroll
    for (int i = 0; i < 4; ++i)
#pragma unroll
        for (int g = 0; g < 4; ++g) { const int col = 32 * i + 8 * g; const f32x4 sb = *(const f32x4*)(subp + col);
            const f32x4 v = (f32x4){oacc[0][i][4 * g], oacc[0][i][4 * g + 1], oacc[0][i][4 * g + 2], oacc[0][i][4 * g + 3]} * rs * sb; *(u32x2*)((char*)o + ob + col * 2) = pk4(v); }
    asm volatile("s_waitcnt lgkmcnt(0)" ::: "memory"); __builtin_amdgcn_s_barrier(); asm volatile("" ::: "memory");
}

#define XB_TMO      128
#define XB_XCNT(j)  (256  + 64 * (j))
#define XB_XSUB(j)  (1280 + 64 * (j))
#define XB_XGEN(j)  (2304 + 64 * (j))
#define XB_TOP      3328
#define XB_TOPGEN   3392
#define XCD_BAR_WORDS 3456
#define XB_SPIN_CAP (1u << 18)
__device__ __forceinline__ unsigned xb_ld(unsigned* p)              { return __hip_atomic_load(p, __ATOMIC_RELAXED, __HIP_MEMORY_SCOPE_AGENT); }
__device__ __forceinline__ unsigned xb_add(unsigned* p, unsigned v) { return __hip_atomic_fetch_add(p, v, __ATOMIC_RELAXED, __HIP_MEMORY_SCOPE_AGENT); }
__device__ __forceinline__ unsigned xb_xcc_id() { return (unsigned)__builtin_amdgcn_s_getreg((3 << 11) | 20) & 0xFu; }
#define XB_SPIN(cond, bar) do { unsigned _sp = 0; while (cond) { __builtin_amdgcn_s_sleep(1); \
    if ((++_sp & 255u) == 0u) { if (xb_ld(&(bar)[XB_TMO])) break; if (_sp > XB_SPIN_CAP) { atomicAdd(&(bar)[XB_TMO], 1u); break; } } } } while (0)
struct XcdBarrier { unsigned* bar; unsigned x; volatile LAS unsigned* st; };
__device__ __forceinline__ XcdBarrier xcd_barrier_post(unsigned* bar, volatile LAS unsigned* st) {
    XcdBarrier b; b.bar = bar; b.x = xb_xcc_id(); b.st = st;
    if (threadIdx.x == 0) (void)xb_add(&bar[XB_XCNT(b.x)], 1u);
    return b;
}
__device__ __forceinline__ void xcd_barrier_complete(unsigned* bar, unsigned x, unsigned& nloc, unsigned& nx) {
    const unsigned G = gridDim.x * gridDim.y * gridDim.z;
    unsigned sum, cnt, mine, sp = 0u;
    for (;;) {
        sum = 0u; cnt = 0u; mine = 0u;
#pragma unroll
        for (unsigned j = 0; j < 16; ++j) { const unsigned c = xb_ld(&bar[XB_XCNT(j)]); sum += c; cnt += (c > 0u) ? 1u : 0u; mine = (j == x) ? c : mine; }
        if (sum == G) break;
        __builtin_amdgcn_s_sleep(1);
        if ((++sp & 255u) == 0u) { if (xb_ld(&bar[XB_TMO])) break; if (sp > XB_SPIN_CAP) { atomicAdd(&bar[XB_TMO], 1u); break; } }
    }
    nloc = mine > 0u ? mine : 1u; nx = cnt > 0u ? cnt : 1u;
}
__device__ __forceinline__ void xcd_barrier(const XcdBarrier& b) {
    asm volatile("s_waitcnt vmcnt(0)" ::: "memory");
    __syncthreads();
    if (threadIdx.x == 0) {
        unsigned* bar = b.bar;
        __builtin_amdgcn_s_waitcnt(0);
        unsigned nloc = b.st[0], nx = b.st[1];
        if (nloc == 0u) { xcd_barrier_complete(bar, b.x, nloc, nx); b.st[0] = nloc; b.st[1] = nx; }
        const unsigned old = xb_add(&bar[XB_XSUB(b.x)], 1u);
        const unsigned gen = old / nloc;
        if (old + 1u == (gen + 1u) * nloc) {
            __builtin_amdgcn_fence(__ATOMIC_RELEASE, "agent");
            asm volatile("s_waitcnt vmcnt(0)" ::: "memory");
            const unsigned og = xb_add(&bar[XB_TOP], 1u);
            const unsigned tg = og / nx;
            if (og + 1u == (tg + 1u) * nx) xb_add(&bar[XB_TOPGEN], 1u);
            else XB_SPIN(xb_ld(&bar[XB_TOPGEN]) == tg, bar);
            __builtin_amdgcn_fence(__ATOMIC_ACQUIRE, "agent");
            xb_add(&bar[XB_XGEN(b.x)], 1u);
            asm volatile("s_waitcnt vmcnt(0)" ::: "memory");
        } else {
            XB_SPIN(xb_ld(&bar[XB_XGEN(b.x)]) == gen, bar);
            __builtin_amdgcn_fence(__ATOMIC_ACQUIRE, "agent");
            asm volatile("s_waitcnt vmcnt(0)" ::: "memory");
        }
    }
    __syncthreads();
}

constexpr int NWAVES = 8, NTHR = 512;
constexpr int RING_BYTES = 131072, LDS_BYTES = 147456, MISC_OFF = LDS_BYTES - 128, SEG_OFF = LDS_BYTES - 8192;
constexpr int CW_BAR = 4096;
constexpr int NPHASE = 3 + 12 * DEPTH;

struct Args { const float* in[28]; int ph_lo, ph_hi; };
enum { I_X = 0, I_C, I_CTX, I_CCTX, I_ADAW, I_ADAB, I_LNG, I_LNB, I_W1, I_W2, I_LIN, I_LCW, I_LCB, I_LGW, I_LGB, I_LLAM, I_LOUT, I_DQKV, I_DLAM, I_DSUB, I_DOUT, I_RQKVG, I_ROUT, I_SQKV, I_SSINK, I_SOUT };

__device__ __forceinline__ unsigned pk2(float lo, float hi) { return cvt_pk_bf16(lo, hi); }
__device__ __forceinline__ void tr_item(const float* W, int ldw, bf16_t* WT, int ldt, int k0, int n0, LAS float* scr, int lane) {
#pragma unroll 8
    for (int i = 0; i < 32; ++i) { const int kk = 2 * i + (lane >> 5); scr[kk * 33 + (lane & 31)] = W[(size_t)(k0 + kk) * ldw + n0 + (lane & 31)]; }
    asm volatile("s_waitcnt lgkmcnt(0)" ::: "memory");
    const int c = lane & 7;
#pragma unroll
    for (int j = 0; j < 4; ++j) { const int n = (lane >> 3) + 8 * j; const LAS float* s = scr + (8 * c) * 33 + n;
        u32x4 o; o.x = pk2(s[0 * 33], s[1 * 33]); o.y = pk2(s[2 * 33], s[3 * 33]); o.z = pk2(s[4 * 33], s[5 * 33]); o.w = pk2(s[6 * 33], s[7 * 33]);
        *(u32x4*)(WT + (size_t)(n0 + n) * ldt + k0 + 8 * c) = o; }
    asm volatile("s_waitcnt lgkmcnt(0)" ::: "memory");
}
__device__ __forceinline__ void tr_job(const float* W, int K, int N, bf16_t* WT, LAS float* scr, int lane, int gw, int NGW, int& base) {
    const int nblk = N / 32, nitems = (K / 64) * nblk;
    for (int it = ((gw - base) % NGW + NGW) % NGW; it < nitems; it += NGW) tr_item(W, N, WT, K, 64 * (it / nblk), 32 * (it % nblk), scr, lane);
    base += nitems;
}

__device__ __forceinline__ const float* input_ptr(const Args& a, int k) { asm volatile("" : "+v"(k)); k = __builtin_amdgcn_readfirstlane(k); return a.in[k]; }
#define PHFN __device__ __forceinline__
PHFN void ph_lru_in(LAS unsigned char* lds, const int tid, unsigned char* ws, int G, int bid) {
    pg8::Order<MapPlain> S; S.init(R / 256, 16, G, bid, D, MapPlain{(const char*)(ws + WS_U), (const char*)(ws + W_LRU_IN), (size_t)256 * D * 2, (size_t)256 * D * 2});
    EpiLruIn E{(bf16_t*)(ws + X_GG), (float*)(ws + X_REC)};
    pg8::gemm_phase<EpiLruIn, pg8::Order<MapPlain>, true>(lds, tid, D, D, D, S, E);
}
PHFN void ph_lru_gate(LAS unsigned char* lds, const int tid, unsigned char* ws, const float* gb, int G, int bid) {
    pg8::Order<MapLruGate> S; S.init(R / 256, 32, G, bid, 256, MapLruGate{(const char*)(ws + X_XCB), (const char*)(ws + W_LRU_G)});
    EpiLruGate E{(const float*)(ws + X_XCF), gb, (const float*)(ws + WS_SP), (bf16_t*)(ws + X_AB), (bf16_t*)(ws + X_BB)};
    pg8::gemm_phase<EpiLruGate, pg8::Order<MapLruGate>, true>(lds, tid, 256, D, 256, S, E);
}
PHFN void ph_qkv(LAS unsigned char* lds, const int tid, unsigned char* ws, int swa, int G, int bid) {
    pg8::Order<MapPlain> S; S.init(R / 256, swa ? 12 : 24, G, bid, D, MapPlain{(const char*)(ws + WS_U), (const char*)(ws + (swa ? W_SWA_QKV : W_DIF_QKV)), (size_t)256 * D * 2, (size_t)256 * D * 2});
    EpiQKV E{(bf16_t*)(ws + X_Q1), (bf16_t*)(ws + X_K1), (bf16_t*)(ws + (swa ? X_VT3 : X_VT1)), swa ? 512 : 2048, swa ? 6 : 7, swa ? 8 : 16};
    pg8::gemm_phase<EpiQKV, pg8::Order<MapPlain>, true>(lds, tid, D, D, D, S, E);
}
PHFN void ph_ret_qkvg(LAS unsigned char* lds, const int tid, unsigned char* ws, int G, int bid) {
    pg8::Order<MapPlain> S; S.init(R / 256, 48, G, bid, D, MapPlain{(const char*)(ws + WS_U), (const char*)(ws + W_RET_QKVG), (size_t)256 * D * 2, (size_t)256 * D * 2});
    EpiRetQKVG E{(bf16_t*)(ws + X_Q2), (bf16_t*)(ws + X_K2), (bf16_t*)(ws + X_KTF), (bf16_t*)(ws + X_KTB), (bf16_t*)(ws + X_A3), (bf16_t*)(ws + X_B3), (bf16_t*)(ws + X_SG)};
    pg8::gemm_phase<EpiRetQKVG, pg8::Order<MapPlain>, true>(lds, tid, D, D, D, S, E);
}
PHFN void ph_ret_s(LAS unsigned char* lds, const int tid, unsigned char* ws, int G, int bid) {
    pg8::Order<MapRetS> S; S.init(R / 256, 8, G, bid, 256, MapRetS{(const char*)(ws + X_Q2), (const char*)(ws + X_K2)});
    EpiRetS E{(bf16_t*)(ws + X_A3)};
    pg8::gemm_phase<EpiRetS, pg8::Order<MapRetS>, true>(lds, tid, 256, D, D, S, E);
}
PHFN void ph_ret_kv(LAS unsigned char* lds, const int tid, unsigned char* ws, int G, int bid) {
    pg8::Order<MapRetKV> S; S.init(R / 256, 32, G, bid, 256, MapRetKV{(const char*)(ws + X_B3), (const char*)(ws + X_KTF), (const char*)(ws + X_KTB)});
    EpiRetKV E{(float*)(ws + X_KVT)};
    pg8::gemm_phase<EpiRetKV, pg8::Order<MapRetKV>, true>(lds, tid, 256, 768, 256, S, E);
}
PHFN void ph_ret_out(LAS unsigned char* lds, const int tid, unsigned char* ws, int G, int bid) {
    pg8::Order<MapRetOut> S; S.init(R / 256, 16, G, bid, 768, MapRetOut{(const char*)(ws + X_A3), (const char*)(ws + X_B3)});
    EpiRetOut E{(float*)(ws + X_O2)};
    pg8::gemm_phase<EpiRetOut, pg8::Order<MapRetOut>, true>(lds, tid, 768, 8 * 768, 768, S, E);
}
template <int K> PHFN void ph_resid(LAS unsigned char* lds, const int tid, unsigned char* ws, const bf16_t* A, const bf16_t* W, int nrows, const float* gate, int G, int bid) {
    OrderResid S{(const char*)A, (const char*)W, K, RL / 256, (nrows - RL) / 256, G, bid};
    EpiResid E{(const float*)(ws + WS_H), (float*)(ws + WS_T), gate, (float*)(ws + X_PARTK)};
    pg8::gemm_phase<EpiResid, OrderResid, true>(lds, tid, K, K, K, S, E);
}
PHFN void ph_up(LAS unsigned char* lds, const int tid, unsigned char* ws, int layer, int nrows, int G, int bid) {
    pg8::Order<MapPlain> S; S.init(nrows / 256, FF / 256, G, bid, D, MapPlain{(const char*)(ws + WS_U), (const char*)(ws + W_MLP1) + (size_t)layer * D * FF * 2, (size_t)256 * D * 2, (size_t)256 * D * 2});
    EpiMlpUp E{(bf16_t*)(ws + X_ACT)};
    pg8::gemm_phase<EpiMlpUp, pg8::Order<MapPlain>, true>(lds, tid, D, D, D, S, E);
}
PHFN void ph_attn_dif(LAS unsigned char* lds, const int tid, unsigned char* ws, const float* dl, const float* subln, int G, int bid) {
    const bf16_t* Q1 = (const bf16_t*)(ws + X_Q1); const bf16_t* K1 = (const bf16_t*)(ws + X_K1); const bf16_t* VT1 = (const bf16_t*)(ws + X_VT1); bf16_t* DO = (bf16_t*)(ws + X_DO);
    const int lane = tid & 63; const float lam_init = 0.8f - 0.6f * 0.7408182206817179f;
    const float s1 = wave_sum(dl[lane] * dl[64 + lane]), s2 = wave_sum(dl[128 + lane] * dl[192 + lane]);
    const float lamf = expf(s1) - expf(s2) + lam_init;
#pragma unroll 1
    for (int u = bid; u < 576; u += G) {
        int b, h, qrow, nt0;
        if (u < 512) { const int qb = u & 7; h = (u >> 3) & 15; b = u >> 7; qrow = b * SEQ + qb * 256; nt0 = 32; }
        else { const int v = u - 512; h = v & 15; b = v >> 4; qrow = RL + b * CTX; nt0 = 0; }
        const int hc = h * 128;
        const bf16_t* vt = VT1 + ((size_t)(b * 16 + h) * 128) * NTOK;
        attn_dif_unit(lds, tid, Q1 + (size_t)qrow * D + hc, K1 + (size_t)(b * SEQ) * D + hc, K1 + (size_t)(RL + b * CTX) * D + hc, vt, vt + SEQ, nt0, 4, lamf, subln, 1.f - lam_init, DO + (size_t)qrow * D + hc);
    }
}
PHFN void ph_attn_swa(LAS unsigned char* lds, const int tid, unsigned char* ws, const float* sink, int G, int bid) {
    const bf16_t* Q3 = (const bf16_t*)(ws + X_Q3); const bf16_t* K3 = (const bf16_t*)(ws + X_K3); const bf16_t* VT3 = (const bf16_t*)(ws + X_VT3); bf16_t* AO = (bf16_t*)(ws + X_AO);
#pragma unroll 1
    for (int u = bid; u < 1024; u += G) {
        const int qb = u & 7, hq = (u >> 3) & 31, b = u >> 8, kvh = hq >> 2; const int qrow = b * SEQ + qb * 256;
        const int klo = qb * 256 - 128 < 0 ? 0 : qb * 256 - 128, khi = qb * 256 + 384 > SEQ ? SEQ : qb * 256 + 384;
        const bf16_t* vt = VT3 + ((size_t)(b * 8 + kvh) * 64) * NTOK;
        attn_unit<64, true>(lds, tid, Q3 + (size_t)qrow * D + hq * 64, D, K3 + (size_t)(b * SEQ + klo) * 512 + kvh * 64, K3 + (size_t)(RL + b * CTX) * 512 + kvh * 64, 512,
                            vt + klo, vt + SEQ, NTOK, (khi - klo) / 64, 4, true, qb * 256, klo, true, sink[hq] * LOG2E, AO + (size_t)qrow * D + hq * 64, D);
    }
}


__device__ __forceinline__ int phase_group(int ph) {
    if (ph < 1) return 0; if (ph < 3) return 1;
    const int layer = (ph - 3) / 12, k = (ph - 3) % 12;
    if (k == 7) return 14; if (k == 8 || k == 11) return 15; if (k == 9) return 16; if (k == 10) return 17;
    if (layer == 0) return k == 0 ? 2 : (k == 2 ? 4 : 3);
    if (layer == 1) return k == 0 ? 5 : 6;
    if (layer == 2) return k == 0 ? 8 : (k <= 2 ? 9 : (k == 4 ? 11 : 10));
    return 12 + k;
}
#ifdef DUP_GROUP
#define REPLOOP(k) _Pragma("unroll 1") for (int rep_ = 0, nrep_ = (phase_group(k) == DUP_GROUP ? 2 : 1); rep_ < nrep_; ++rep_)
#define NBAR (DUP_GROUP == 18 ? 2 : 1)
#else
#define REPLOOP(k)
#define NBAR 1
#endif
__global__ void __launch_bounds__(NTHR, 2) fwd(Args args) {
    extern __shared__ __attribute__((aligned(16))) unsigned char lds_raw[];
    LAS unsigned char* lds = (LAS unsigned char*)lds_raw;
    for (int u = threadIdx.x; u < (LDS_BYTES - RING_BYTES) / 4; u += NTHR) ((LAS unsigned*)(lds + RING_BYTES))[u] = 0u;
    __syncthreads();
    (void)xcd_barrier_post((unsigned*)((unsigned char*)input_ptr(args, 27) + WS_CTL) + CW_BAR, (volatile LAS unsigned*)(lds + MISC_OFF) + 8);
#ifdef PH_TEST
    const int lo = PH_TEST, hi = PH_TEST + 1;
#else
    const int lo = args.ph_lo, hi = args.ph_hi;
#endif
#define IN(k) (lo <= (k) && (k) < hi)
#define PH_BEGIN() int tid = threadIdx.x, bid = blockIdx.x, G = gridDim.x; unsigned char* ws = (unsigned char*)input_ptr(args, 27); \
    asm volatile("" : "+v"(tid), "+v"(bid), "+v"(G)); bid = __builtin_amdgcn_readfirstlane(bid); G = __builtin_amdgcn_readfirstlane(G); \
    const int lane = tid & 63, wave = __builtin_amdgcn_readfirstlane(tid >> 6); \
    const int gw = bid * NWAVES + wave, NGW = G * NWAVES; const size_t gtid = (size_t)bid * NTHR + tid, NGT = (size_t)G * NTHR; \
    (void)lane; (void)wave; (void)gw; (void)NGW; (void)gtid; (void)NGT; \
    float* MOD = (float*)(ws + WS_MOD); float* SP = (float*)(ws + WS_SP); float* PART = (float*)(ws + WS_PART); \
    float* Hs = (float*)(ws + WS_H); float* Ts = (float*)(ws + WS_T); bf16_t* Us = (bf16_t*)(ws + WS_U); \
    (void)MOD; (void)SP; (void)PART; (void)Hs; (void)Ts; (void)Us;
#define INP(k) input_ptr(args, (k))
#define SEAM(k) do { if ((k) + 1 < hi) { unsigned char* wsb = (unsigned char*)input_ptr(args, 27); XcdBarrier bar; bar.bar = (unsigned*)(wsb + WS_CTL) + CW_BAR; bar.x = xb_xcc_id(); \
    bar.st = (volatile LAS unsigned*)(lds + MISC_OFF) + 8; for (int nb_ = 0; nb_ < NBAR; ++nb_) xcd_barrier(bar); } } while (0)

    if (IN(0)) { REPLOOP(0) { PH_BEGIN();
        LAS float* sl = (LAS float*)(lds + 81920);
        for (int i = tid; i < 5 * D; i += NTHR) { const int r = i >> 11, k = i & (D - 1); const float v = r < 4 ? INP(I_C)[r * D + k] : INP(I_CCTX)[k]; sl[i] = siluf(v); }
        __syncthreads();
        for (int task = gw; task < 4 * 8 * 48; task += NGW) {
            const int cc = task % 48, ks = (task / 48) & 7, l = task / 384; const int n0 = cc * 256 + lane * 4;
            const float* wp = INP(I_ADAW) + ((size_t)l * D + ks * 256) * MODW + n0;
            f32x4 a0 = {0, 0, 0, 0}, a1 = a0, a2 = a0, a3 = a0, a4 = a0;
#pragma unroll 8
            for (int k = 0; k < 256; ++k) { const f32x4 wv = *(const f32x4*)(wp + (size_t)k * MODW); const int kk = ks * 256 + k;
                a0 += wv * sl[kk]; a1 += wv * sl[D + kk]; a2 += wv * sl[2 * D + kk]; a3 += wv * sl[3 * D + kk]; a4 += wv * sl[4 * D + kk]; }
            float* pp = PART + ((size_t)(ks * 4 + l) * 5) * MODW + n0;
            *(f32x4*)(pp) = a0; *(f32x4*)(pp + MODW) = a1; *(f32x4*)(pp + 2 * MODW) = a2; *(f32x4*)(pp + 3 * MODW) = a3; *(f32x4*)(pp + 4 * MODW) = a4;
        }
        LAS float* scr = (LAS float*)(lds + wave * 8448);
        int base = 0;
        tr_job(INP(I_LIN), D, 4096, (bf16_t*)(ws + W_LRU_IN), scr, lane, gw, NGW, base);
        {
            const int nitems = 64 * 16;
            for (int it = ((gw - base) % NGW + NGW) % NGW; it < nitems; it += NGW) { const int sb = it >> 4, kb = (it >> 2) & 3, nb = it & 3;
                const int half = sb & 1, blk = (sb >> 1) & 7, g = (sb >> 4) & 1, dir = sb >> 5;
                const float* src = INP(I_LGW) + (size_t)(((dir * 2 + g) * 8 + blk)) * 65536 + half * 128;
                bf16_t* dst = (bf16_t*)(ws + W_LRU_G) + ((size_t)(((dir * 8 + blk) * 2 + half) * 256 + g * 128)) * 256;
                tr_item(src, 256, dst, 256, 64 * kb, 32 * nb, scr, lane); }
            base += nitems;
        }
        tr_job(INP(I_LOUT), D, D, (bf16_t*)(ws + W_LRU_OUT), scr, lane, gw, NGW, base);
        tr_job(INP(I_DQKV), D, 6144, (bf16_t*)(ws + W_DIF_QKV), scr, lane, gw, NGW, base);
        tr_job(INP(I_DOUT), D, D, (bf16_t*)(ws + W_DIF_OUT), scr, lane, gw, NGW, base);
        tr_job(INP(I_RQKVG), D, 12288, (bf16_t*)(ws + W_RET_QKVG), scr, lane, gw, NGW, base);
        tr_job(INP(I_ROUT), 4096, D, (bf16_t*)(ws + W_RET_OUT), scr, lane, gw, NGW, base);
        tr_job(INP(I_SQKV), D, 3072, (bf16_t*)(ws + W_SWA_QKV), scr, lane, gw, NGW, base);
        tr_job(INP(I_SOUT), D, D, (bf16_t*)(ws + W_SWA_OUT), scr, lane, gw, NGW, base);
#pragma unroll 1
        for (int l = 0; l < DEPTH; ++l) {
            tr_job(INP(I_W1) + (size_t)l * D * FF, D, FF, (bf16_t*)(ws + W_MLP1) + (size_t)l * D * FF, scr, lane, gw, NGW, base);
            tr_job(INP(I_W2) + (size_t)l * D * FF, FF, D, (bf16_t*)(ws + W_MLP2) + (size_t)l * D * FF, scr, lane, gw, NGW, base);
        }
        __syncthreads();
        } SEAM(0);
    }
    if (IN(1)) { REPLOOP(1) { PH_BEGIN();
        for (size_t i = gtid; i < (size_t)4 * 5 * MODW; i += NGT) { const int n = (int)(i % MODW); const int l = (int)(i / (5 * MODW));
            float s = INP(I_ADAB)[l * MODW + n];
#pragma unroll
            for (int ks = 0; ks < 8; ++ks) s += PART[(size_t)ks * 4 * 5 * MODW + i];
            MOD[i] = s; }
        for (size_t i = gtid; i < 2 * D; i += NGT) { const float lam = INP(I_LLAM)[i]; const float x = ex2(-lam * LOG2E);
            const float sp = x < 0.05f ? x * (1.f + x * (-0.5f + x * (1.f / 3.f + x * (-0.25f + x * (0.2f - x * (1.f / 6.f)))))) : logf(1.f + x);
            SP[i] = -8.f * sp; }
        } SEAM(1);
    }
    if (IN(2)) { REPLOOP(2) { PH_BEGIN();
        for (size_t i = gtid; i < (size_t)R * (D / 4); i += NGT) { const int row = (int)(i >> 9), c4 = (int)(i & 511) * 4;
            const f32x4 v = row < RL ? *(const f32x4*)(INP(I_X) + (size_t)row * D + c4) : *(const f32x4*)(INP(I_CTX) + (size_t)(row - RL) * D + c4);
            const float* mp = MOD + (size_t)mod_row(row) * MODW; const f32x4 sh = *(const f32x4*)(mp + c4), sc = *(const f32x4*)(mp + D + c4);
            *(f32x4*)(Hs + (size_t)row * D + c4) = v; *(u32x2*)(Us + (size_t)row * D + c4) = pk4(v * (sc + 1.f) + sh); }
        } SEAM(2);
    }

#pragma unroll 1
    for (int layer = 0; layer < DEPTH; ++layer) {
        const int Lb = 3 + 12 * layer;
        const int nrows = layer == DEPTH - 1 ? RL : R;
#define LAYER_VARS() const float* modl = MOD + (size_t)layer * 5 * MODW; (void)modl; \
        const bf16_t* YIN = (const bf16_t*)(ws + (layer == 0 ? X_YIN : layer == 1 ? X_DO : layer == 2 ? X_RO : X_AO)); (void)YIN; \
        const bf16_t* WOUT = (const bf16_t*)(ws + (layer == 0 ? W_LRU_OUT : layer == 1 ? W_DIF_OUT : layer == 2 ? W_RET_OUT : W_SWA_OUT)); (void)WOUT;

        if (layer == 0) {
#define LRU_VARS() bf16_t* GG = (bf16_t*)(ws + X_GG); float* REC = (float*)(ws + X_REC); bf16_t* XCB = (bf16_t*)(ws + X_XCB); float* XCF = (float*)(ws + X_XCF); \
            bf16_t* AB = (bf16_t*)(ws + X_AB); bf16_t* BB = (bf16_t*)(ws + X_BB); float* CAR = (float*)(ws + X_CARRY); bf16_t* YO = (bf16_t*)(ws + X_YIN); \
            (void)GG; (void)REC; (void)XCB; (void)XCF; (void)AB; (void)BB; (void)CAR; (void)YO;
            if (IN(Lb + 0)) { REPLOOP(Lb + 0) { PH_BEGIN(); ph_lru_in(lds, tid, ws, G, bid); } SEAM(Lb + 0); }
            if (IN(Lb + 1)) { REPLOOP(Lb + 1) { PH_BEGIN(); LRU_VARS();
                const float* cw = INP(I_LCW); const float* cb = INP(I_LCB);
                for (size_t i = gtid; i < (size_t)R * (D / 4); i += NGT) { const int row = (int)(i >> 9), c4 = (int)(i & 511) * 4;
                    const int t = row < RL ? (row & (SEQ - 1)) : ((row - RL) & (CTX - 1)), len = row < RL ? SEQ : CTX;
                    f32x4 a = *(const f32x4*)(cb + c4);
#pragma unroll
                    for (int k = 0; k < 4; ++k) { const int tt = t + k - 2; if (tt >= 0 && tt < len) a += *(const f32x4*)(cw + k * D + c4) * *(const f32x4*)(REC + (size_t)(row + k - 2) * D + c4); }
                    *(f32x4*)(XCF + (size_t)row * D + c4) = a; *(u32x2*)(XCB + (size_t)row * D + c4) = pk4(a); }
                } SEAM(Lb + 1);
            }
            if (IN(Lb + 2)) { REPLOOP(Lb + 2) { PH_BEGIN(); ph_lru_gate(lds, tid, ws, INP(I_LGB), G, bid); } SEAM(Lb + 2); }
            if (IN(Lb + 3)) { REPLOOP(Lb + 3) { PH_BEGIN(); LRU_VARS();
                LAS float* Al = (LAS float*)lds; LAS float* Bl = (LAS float*)(lds + 65536); LAS float* seg = (LAS float*)(lds + SEG_OFF);
                bf16_t* PC = (bf16_t*)(ws + X_PC); bf16_t* HL = (bf16_t*)(ws + X_HL);
                const int ch = tid & 63, sg = tid >> 6;
#pragma unroll 1
                for (int task = bid; task < 2 * 36 * 32; task += G) { const int cg = task & 31, pm = (task >> 5) % 36, dir = task / (36 * 32); const int ch0 = cg * 64;
                    const bf16_t* ag = AB + ((size_t)dir * R + pm * 256) * D + ch0; const bf16_t* bg = BB + ((size_t)dir * R + pm * 256) * D + ch0;
#pragma unroll
                    for (int i = 0; i < 8; ++i) { const int e = tid + 512 * i, r = e >> 4, c4 = (e & 15) * 4; const u32x2 wa = *(const u32x2*)(ag + (size_t)r * D + c4), wb = *(const u32x2*)(bg + (size_t)r * D + c4);
                        *(LAS f32x4*)(Al + r * 64 + c4) = (f32x4){1.f - __uint_as_float(wa.x << 16), 1.f - __uint_as_float(wa.x & 0xffff0000u), 1.f - __uint_as_float(wa.y << 16), 1.f - __uint_as_float(wa.y & 0xffff0000u)};
                        *(LAS f32x4*)(Bl + r * 64 + c4) = (f32x4){__uint_as_float(wb.x << 16), __uint_as_float(wb.x & 0xffff0000u), __uint_as_float(wb.y << 16), __uint_as_float(wb.y & 0xffff0000u)}; }
                    __syncthreads();
                    float p = 1.f, h = 0.f;
#pragma unroll 8
                    for (int i = 0; i < 32; ++i) { const int r = dir == 0 ? 32 * sg + i : 255 - (32 * sg + i); const float a = Al[r * 64 + ch], b = Bl[r * 64 + ch]; p *= a; h = a * h + b; Al[r * 64 + ch] = p; Bl[r * 64 + ch] = h; }
                    seg[(sg * 64 + ch) * 2] = p; seg[(sg * 64 + ch) * 2 + 1] = h;
                    __syncthreads();
                    float cp = 1.f, chh = 0.f;
                    for (int k = 0; k < sg; ++k) { const float sp_ = seg[(k * 64 + ch) * 2], sh_ = seg[(k * 64 + ch) * 2 + 1]; chh = sp_ * chh + sh_; cp *= sp_; }
                    if (sg == 7) { float* cpz = CAR + ((size_t)(dir * 36 + pm) * 2) * D + ch0 + ch; cpz[0] = cp * p; cpz[D] = p * chh + h; }
                    const size_t ob = ((size_t)dir * R + pm * 256) * D + ch0 + ch;
#pragma unroll 8
                    for (int i = 0; i < 32; ++i) { const int r = dir == 0 ? 32 * sg + i : 255 - (32 * sg + i); const float pl = Al[r * 64 + ch], hl = Bl[r * 64 + ch];
                        PC[ob + (size_t)r * D] = f2bf(pl * cp); HL[ob + (size_t)r * D] = f2bf(hl + pl * chh); }
                    __syncthreads();
                }
                } SEAM(Lb + 3);
            }
            if (IN(Lb + 4)) { REPLOOP(Lb + 4) { PH_BEGIN(); LRU_VARS();
                float* CIN = (float*)(ws + X_CIN);
                for (size_t i = gtid; i < (size_t)NB * 2 * D; i += NGT) { const int ch = (int)(i & (D - 1)), dir = (int)(i >> 11) & 1, b = (int)(i >> 12);
                    float h = 0.f;
#pragma unroll 1
                    for (int s = 0; s < 9; ++s) { const int pm = s == 0 ? 32 + b : (dir == 0 ? b * 8 + (s - 1) : b * 8 + (8 - s));
                        CIN[((size_t)dir * 36 + pm) * D + ch] = h; const float* cp = CAR + ((size_t)(dir * 36 + pm) * 2) * D + ch; h = cp[0] * h + cp[D]; } }
                } SEAM(Lb + 4);
            }
            if (IN(Lb + 5)) { REPLOOP(Lb + 5) { PH_BEGIN(); LRU_VARS();
                const float* CIN = (const float*)(ws + X_CIN); const bf16_t* PC = (const bf16_t*)(ws + X_PC); const bf16_t* HL = (const bf16_t*)(ws + X_HL);
                for (size_t i = gtid; i < (size_t)R * (D / 4); i += NGT) { const int row = (int)(i >> 9), c4 = (int)(i & 511) * 4, pm = row >> 8; const size_t o = (size_t)row * D + c4;
                    const u32x2 pf = *(const u32x2*)(PC + o), hf = *(const u32x2*)(HL + o), pb = *(const u32x2*)(PC + (size_t)R * D + o), hb = *(const u32x2*)(HL + (size_t)R * D + o), gg = *(const u32x2*)(GG + o);
                    const f32x4 cf = *(const f32x4*)(CIN + (size_t)pm * D + c4), cb = *(const f32x4*)(CIN + ((size_t)36 + pm) * D + c4);
#define UNPK(w) (f32x4){__uint_as_float((w).x << 16), __uint_as_float((w).x & 0xffff0000u), __uint_as_float((w).y << 16), __uint_as_float((w).y & 0xffff0000u)}
                    const f32x4 y = UNPK(gg) * ((UNPK(hf) + UNPK(pf) * cf) + (UNPK(hb) + UNPK(pb) * cb));
#undef UNPK
                    *(u32x2*)(YO + o) = pk4(y); }
                } SEAM(Lb + 5);
            }
        } else if (layer == 1) {
            if (IN(Lb + 0)) { REPLOOP(Lb + 0) { PH_BEGIN(); ph_qkv(lds, tid, ws, 0, G, bid); } SEAM(Lb + 0); }
            if (IN(Lb + 1)) { REPLOOP(Lb + 1) { PH_BEGIN(); ph_attn_dif(lds, tid, ws, INP(I_DLAM), INP(I_DSUB), G, bid); } SEAM(Lb + 1); }
        } else if (layer == 2) {
            if (IN(Lb + 0)) { REPLOOP(Lb + 0) { PH_BEGIN(); ph_ret_qkvg(lds, tid, ws, G, bid); } SEAM(Lb + 0); }
            if (IN(Lb + 1)) { REPLOOP(Lb + 1) { PH_BEGIN(); ph_ret_s(lds, tid, ws, G, bid); } SEAM(Lb + 1); }
            if (IN(Lb + 2)) { REPLOOP(Lb + 2) { PH_BEGIN(); ph_ret_kv(lds, tid, ws, G, bid); } SEAM(Lb + 2); }
            if (IN(Lb + 3)) { REPLOOP(Lb + 3) { PH_BEGIN(); bf16_t* B3 = (bf16_t*)(ws + X_B3); float* KVT = (float*)(ws + X_KVT);
                for (size_t i = gtid; i < (size_t)64 * 32768; i += NGT) { const int e4 = (int)(i & 32767), hd = (int)(i >> 15) & 15, b = (int)(i >> 19);
                    const int h = hd >> 1, dir = hd & 1; const int dv = e4 >> 6, dk = (e4 & 63) * 4;
                    const float cdec = ex2(256.f * ret_log2g(dir ? 7 - h : h));
                    f32x4 acc = {0.f, 0.f, 0.f, 0.f};
#pragma unroll 1
                    for (int s = 0; s < 9; ++s) { const int pm = s == 0 ? 32 + b : (dir == 0 ? b * 8 + (s - 1) : b * 8 + (8 - s));
                        *(u32x2*)(B3 + (((size_t)pm * 8 + h) * 512 + dv) * 768 + dir * 256 + dk) = pk4(acc);
                        acc = acc * cdec + *(const f32x4*)(KVT + (((size_t)pm * 16 + hd) * 512 + dv) * 256 + dk); }
                }
                } SEAM(Lb + 3);
            }
            if (IN(Lb + 4)) { REPLOOP(Lb + 4) { PH_BEGIN(); ph_ret_out(lds, tid, ws, G, bid); } SEAM(Lb + 4); }
            if (IN(Lb + 5)) { REPLOOP(Lb + 5) { PH_BEGIN(); float* O2 = (float*)(ws + X_O2); bf16_t* RO = (bf16_t*)(ws + X_RO); bf16_t* SG = (bf16_t*)(ws + X_SG);
                for (int row = gw; row < R; row += NGW) {
#pragma unroll
                    for (int hh = 0; hh < 8; ++hh) { const size_t o = (size_t)row * 4096 + hh * 512 + lane * 4; const f32x4 v0 = *(const f32x4*)(O2 + o), v1 = *(const f32x4*)(O2 + o + 256);
                        const float ss = wave_sum((v0[0] * v0[0] + v0[1] * v0[1]) + (v0[2] * v0[2] + v0[3] * v0[3]) + (v1[0] * v1[0] + v1[1] * v1[1]) + (v1[2] * v1[2] + v1[3] * v1[3]));
                        const float rs = 1.f / sqrtf(ss * (1.f / 512.f) + LN_EPS);
                        const u32x2 g0 = *(const u32x2*)(SG + o), g1 = *(const u32x2*)(SG + o + 256);
                        f32x4 ga, gb2; ga[0] = __uint_as_float(g0.x << 16); ga[1] = __uint_as_float(g0.x & 0xffff0000u); ga[2] = __uint_as_float(g0.y << 16); ga[3] = __uint_as_float(g0.y & 0xffff0000u);
                        gb2[0] = __uint_as_float(g1.x << 16); gb2[1] = __uint_as_float(g1.x & 0xffff0000u); gb2[2] = __uint_as_float(g1.y << 16); gb2[3] = __uint_as_float(g1.y & 0xffff0000u);
                        *(u32x2*)(RO + o) = pk4(v0 * rs * ga); *(u32x2*)(RO + o + 256) = pk4(v1 * rs * gb2); }
                }
                } SEAM(Lb + 5);
            }
        } else {
            if (IN(Lb + 0)) { REPLOOP(Lb + 0) { PH_BEGIN(); ph_qkv(lds, tid, ws, 1, G, bid); } SEAM(Lb + 0); }
            if (IN(Lb + 1)) { REPLOOP(Lb + 1) { PH_BEGIN(); ph_attn_swa(lds, tid, ws, INP(I_SSINK), G, bid); } SEAM(Lb + 1); }
        }

        if (IN(Lb + 7)) { REPLOOP(Lb + 7) { PH_BEGIN(); LAYER_VARS(); if (layer == 2) ph_resid<4096>(lds, tid, ws, YIN, WOUT, nrows, modl + 2 * D, G, bid); else ph_resid<D>(lds, tid, ws, YIN, WOUT, nrows, modl + 2 * D, G, bid); } SEAM(Lb + 7); }
#pragma unroll 1
        for (int which = 0; which < 2; ++which) {
            if (which == 1) {
                if (IN(Lb + 9)) { REPLOOP(Lb + 9) { PH_BEGIN(); ph_up(lds, tid, ws, layer, nrows, G, bid); } SEAM(Lb + 9); }
                if (IN(Lb + 10)) { REPLOOP(Lb + 10) { PH_BEGIN(); LAYER_VARS(); ph_resid<FF>(lds, tid, ws, (const bf16_t*)(ws + X_ACT), (const bf16_t*)(ws + W_MLP2) + (size_t)layer * D * FF, nrows, modl + 5 * D, G, bid); } SEAM(Lb + 10); }
            }
            const int pid = Lb + (which == 0 ? 8 : 11);
            if (IN(pid)) { REPLOOP(pid) { PH_BEGIN(); LAYER_VARS();
                const float* lg = INP(I_LNG) + (size_t)(layer * 2 + which) * D; const float* lb = INP(I_LNB) + (size_t)(layer * 2 + which) * D;
                const bool fin = (layer == DEPTH - 1 && which == 1);
                const float* mbase = which == 0 ? modl + 3 * D : modl + 5 * MODW;
                for (int t = gw; t < 2048; t += NGW) {
                  int r0, nr, rc = -1;
                  if (nrows == RL) { r0 = 4 * t; nr = 4; } else if (t < 1024) { rc = RL + t; r0 = 3 * t; nr = 3; } else { r0 = 3072 + (t - 1024) * 5; nr = 5; }
#pragma unroll 1
                  for (int q = (rc >= 0 ? -1 : 0); q < nr; ++q) { const int row = q < 0 ? rc : r0 + q;
                    const float* tp = Ts + (size_t)row * D + lane * 4;
                    f32x4 v[8]; float s = 0.f;
if (row < RL) {
#pragma unroll
                        for (int j = 0; j < 8; ++j) v[j] = *(const f32x4*)(tp + 256 * j);
                    } else {
                        const float* hp0 = Hs + (size_t)row * D + lane * 4; const float* gp = modl + 4 * MODW + (which == 0 ? 2 : 5) * D + lane * 4;
                        const float* pk = (const float*)(ws + X_PARTK) + (size_t)(row - RL) * D + lane * 4;
#pragma unroll
                        for (int j = 0; j < 8; ++j) { f32x4 a = *(const f32x4*)(pk + 256 * j);
#pragma unroll
                            for (int ks = 1; ks < 8; ++ks) a += *(const f32x4*)(pk + (size_t)ks * RC * D + 256 * j);
                            v[j] = *(const f32x4*)(hp0 + 256 * j) * ALPHA + *(const f32x4*)(gp + 256 * j) * a; }
                    }
#pragma unroll
                    for (int j = 0; j < 8; ++j) s += (v[j][0] + v[j][1]) + (v[j][2] + v[j][3]);
                    const float mean = wave_sum(s) * (1.f / D); float s2 = 0.f;
#pragma unroll
                    for (int j = 0; j < 8; ++j) { v[j] = v[j] - mean; s2 += (v[j][0] * v[j][0] + v[j][1] * v[j][1]) + (v[j][2] * v[j][2] + v[j][3] * v[j][3]); }
                    const float rstd = 1.f / sqrtf(wave_sum(s2) * (1.f / D) + LN_EPS);
                    const float* mp = mbase + (size_t)mod_row(row) * MODW;
                    float* hp = (fin ? (float*)input_ptr(args, 26) : Hs) + (size_t)row * D + lane * 4;
#pragma unroll
                    for (int j = 0; j < 8; ++j) { const int c = lane * 4 + 256 * j; const f32x4 y = v[j] * rstd * *(const f32x4*)(lg + c) + *(const f32x4*)(lb + c);
                        *(f32x4*)(hp + 256 * j) = y;
                        if (!fin) { const f32x4 sh = *(const f32x4*)(mp + c), sc = *(const f32x4*)(mp + D + c); *(u32x2*)(Us + (size_t)row * D + c) = pk4(y * (sc + 1.f) + sh); } }
                  }
                }
                } SEAM(pid);
            }
        }
    }
#undef IN
#undef SEAM
}

__global__ void marker_kernel(float* out, int n, float v) { const int i = blockIdx.x * blockDim.x + threadIdx.x; if (i < n) out[i] = v; }

static bool phase_used(int ph) {
    if (ph < 3) return true;
    const int layer = (ph - 3) / 12, k = (ph - 3) % 12;
    if (k >= 7) return true;
    const int nmix[4] = {6, 2, 6, 2};
    return k < nmix[layer];
}

extern "C" void kernel_launch(void* const* d_in, const int* in_sizes, int n_in, void* d_out, int out_size, void* d_ws, size_t ws_size, hipStream_t stream) {
    static int grid = 0;
    if (grid == 0) {
        int dev = 0, cus = 0;
        if (hipGetDevice(&dev) != hipSuccess || hipDeviceGetAttribute(&cus, hipDeviceAttributeMultiprocessorCount, dev) != hipSuccess) { grid = -1; }
        else if (hipFuncSetAttribute((const void*)fwd, hipFuncAttributeMaxDynamicSharedMemorySize, LDS_BYTES) != hipSuccess) { fprintf(stderr, "kernel_launch: hipFuncSetAttribute failed\n"); grid = -1; }
        else { int per_cu = 0; (void)hipOccupancyMaxActiveBlocksPerMultiprocessor(&per_cu, (const void*)fwd, NTHR, LDS_BYTES); (void)hipGetLastError(); grid = cus; }
    }
    if (grid < 0 || n_in != 26 || out_size != RL * D || ws_size < WS_END) {
        fprintf(stderr, "kernel_launch: bad configuration (grid %d n_in %d out %d ws %zu need %zu)\n", grid, n_in, out_size, ws_size, (size_t)WS_END);
        hipLaunchKernelGGL(marker_kernel, dim3((out_size + 255) / 256), dim3(256), 0, stream, (float*)d_out, out_size, ws_size < WS_END ? 1000.f : 3000.f);
        return;
    }
    (void)hipMemsetAsync((char*)d_ws + WS_CTL, 0, CTL_BYTES, stream);
    Args a{};
    for (int i = 0; i < 26; ++i) a.in[i] = (const float*)d_in[i];
    a.in[26] = (const float*)d_out; a.in[27] = (const float*)d_ws;
#if MK_MULTI
    for (int ph = 0; ph < NPHASE; ++ph) { if (!phase_used(ph)) continue; a.ph_lo = ph; a.ph_hi = ph + 1; hipLaunchKernelGGL(fwd, dim3(grid), dim3(NTHR), LDS_BYTES, stream, a); }
#else
    a.ph_lo = 0; a.ph_hi = NPHASE;
    hipLaunchKernelGGL(fwd, dim3(grid), dim3(NTHR), LDS_BYTES, stream, a);
#endif
}
```
